# Optimizing an MI355X kernel written in HIP

```python
import math
import jax, jax.numpy as jnp
from jax import lax
import numpy as np


D_MODEL = 1024
BATCH = 8
SEQ = 8192
DEPTH = 2

CHUNK = 64
Q_BLOCK = 128
HEAD_DIM = 64
N_GROUP_HEADS = 4
GROUP_WIDTH = N_GROUP_HEADS * HEAD_DIM
N_GROUPS = 4
D_MIX = N_GROUPS * GROUP_WIDTH
ROPE_THETA = 500000.0
RET_THETA = 10000.0
KV_RANK = 128
IDX_HEADS = 8
IDX_DIM = 64
TOPK_MAX = 256
DIFF_HALF = HEAD_DIM // 2
EPS = 1e-6

IN_SIZES = (
    GROUP_WIDTH, KV_RANK, IDX_HEADS * IDX_DIM, IDX_DIM, IDX_HEADS, GROUP_WIDTH,
    GROUP_WIDTH, GROUP_WIDTH, GROUP_WIDTH, GROUP_WIDTH,
    GROUP_WIDTH, GROUP_WIDTH, GROUP_WIDTH, GROUP_WIDTH,
    GROUP_WIDTH, GROUP_WIDTH, GROUP_WIDTH, GROUP_WIDTH,
)
D_IN = 14 * GROUP_WIDTH + KV_RANK + IDX_HEADS * IDX_DIM + IDX_DIM + IDX_HEADS

kernel_name = 'hybrid_head_group_streaming_encoder'


def _rms(x, g=None):
    xf = x.astype(jnp.float32)
    y = xf * lax.rsqrt(jnp.mean(xf * xf, axis=-1, keepdims=True) + EPS)
    if g is not None:
        y = y * g.astype(jnp.float32)
    return y.astype(x.dtype)


def _rope(x, pos, theta, rot_dim):
    half = rot_dim // 2
    inv = theta ** (-jnp.arange(half, dtype=jnp.float32) * 2.0 / rot_dim)
    ang = pos.astype(jnp.float32)[..., None] * inv
    cos = jnp.cos(ang)[:, :, None, :]
    sin = jnp.sin(ang)[:, :, None, :]
    xr = x[..., :rot_dim].astype(jnp.float32)
    x1, x2 = xr[..., :half], xr[..., half:]
    rot = jnp.concatenate([x1 * cos - x2 * sin, x2 * cos + x1 * sin], axis=-1)
    return jnp.concatenate([rot.astype(x.dtype), x[..., rot_dim:]], axis=-1)


def _split(t, sizes):
    return jnp.split(t, np.cumsum(sizes)[:-1].tolist(), axis=-1)


def _qslice(t, i):
    return lax.dynamic_slice_in_dim(t, i * Q_BLOCK, Q_BLOCK, axis=1)


def _sweep(block_fn, S):
    out = lax.map(block_fn, jnp.arange(S // Q_BLOCK))
    nb, B, qb, H, e = out.shape
    return jnp.moveaxis(out, 0, 1).reshape(B, nb * qb, H, e)


def _chunk_mask(tq, S):
    end = (tq // CHUNK + 1) * CHUNK
    return jnp.arange(S)[None, :] < end[:, None], end


def _dsa(q, k, v, q_idx, k_idx, w_idx):
    S = q.shape[1]
    topk = min(TOPK_MAX, S // 4)
    ts = jnp.arange(S)
    idx_scale = (IDX_HEADS * IDX_DIM) ** -0.5

    def block(i):
        tq = i * Q_BLOCK + jnp.arange(Q_BLOCK)
        _, end = _chunk_mask(tq, S)
        rel = jax.nn.relu(jnp.einsum('bqhd,bsd->bqhs', _qslice(q_idx, i), k_idx).astype(jnp.float32))
        score = jnp.einsum('bqhs,bqh->bqs', rel, _qslice(w_idx, i).astype(jnp.float32)) * idx_scale
        score = jnp.where(ts[None, None, :] < end[None, :, None], score, -jnp.inf)
        _, sel = lax.top_k(score, topk)
        valid = sel < end[None, :, None]
        k_sel = jax.vmap(lambda kb, ib: kb[ib])(k, sel)
        v_sel = jax.vmap(lambda vb, ib: vb[ib])(v, sel)
        logits = jnp.einsum('bqhd,bqkd->bqhk', _qslice(q, i), k_sel).astype(jnp.float32) * HEAD_DIM ** -0.5
        logits = jnp.where(valid[:, :, None, :], logits, -jnp.inf)
        p = jax.nn.softmax(logits, axis=-1)
        return jnp.einsum('bqhk,bqkd->bqhd', p.astype(v.dtype), v_sel)

    return _sweep(block, S)


def _retention(q, k, v, g):
    B, S, H, d = q.shape
    e = v.shape[-1]
    nc = S // CHUNK
    log_gamma = jnp.log1p(-(2.0 ** (-5.0 - jnp.arange(H, dtype=jnp.float32))))
    pos_c = jnp.arange(CHUNK, dtype=jnp.float32)
    intra_decay = jnp.exp(log_gamma[:, None, None] * jnp.abs(pos_c[:, None] - pos_c[None, :]))
    k_decay = jnp.exp(log_gamma[:, None] * (CHUNK - 1 - pos_c))
    q_decay = jnp.exp(log_gamma[:, None] * (pos_c + 1.0))
    chunk_decay = jnp.exp(log_gamma * CHUNK)
    qc = q.astype(jnp.float32).reshape(B, nc, CHUNK, H, d)
    kc = k.astype(jnp.float32).reshape(B, nc, CHUNK, H, d) * d ** -0.5
    vc = v.astype(jnp.float32).reshape(B, nc, CHUNK, H, e)
    s_intra = jnp.einsum('bnihd,bnjhd->bnhij', qc, kc) * intra_decay
    y = jnp.einsum('bnhij,bnjhe->bnihe', s_intra, vc)
    kv = jnp.einsum('bnjhd,bnjhe,hj->nbhde', kc, vc, k_decay)

    def step(state, kv_n):
        return chunk_decay[None, :, None, None] * state + kv_n, state

    _, states = lax.scan(step, jnp.zeros((B, H, d, e), jnp.float32), kv)
    y = y + jnp.einsum('bnihd,nbhde,hi->bnihe', qc, states, q_decay)
    y = y.reshape(B, S, H, e)
    mu = jnp.mean(y, axis=-1, keepdims=True)
    var = jnp.mean(jnp.square(y - mu), axis=-1, keepdims=True)
    y = ((y - mu) * lax.rsqrt(var + EPS)).reshape(B, S, H * e) * g.astype(jnp.float32)
    return y.astype(v.dtype)


def _diff_attn(q1, q2, k1, k2, v, lam):
    S = q1.shape[1]
    scale = DIFF_HALF ** -0.5

    def block(i):
        tq = i * Q_BLOCK + jnp.arange(Q_BLOCK)
        mask, _ = _chunk_mask(tq, S)

        def probs(qh, kh):
            s = jnp.einsum('bqhd,bshd->bhqs', _qslice(qh, i), kh).astype(jnp.float32) * scale
            return jax.nn.softmax(jnp.where(mask, s, -jnp.inf), axis=-1)

        a = probs(q1, k1) - lam * probs(q2, k2)
        return jnp.einsum('bhqs,bshe->bqhe', a.astype(v.dtype), v)

    return _sweep(block, S)


def _stick_breaking(q, k, v):
    S = q.shape[1]
    ts = jnp.arange(S)

    def block(i):
        tq = i * Q_BLOCK + jnp.arange(Q_BLOCK)
        strict = ts[None, :] < tq[:, None]
        z = jnp.einsum('bqhd,bshd->bhqs', _qslice(q, i), k).astype(jnp.float32) * HEAD_DIM ** -0.5
        log_1m = jnp.where(strict, jax.nn.log_sigmoid(-z), 0.0)
        log_rest = lax.cumsum(log_1m, axis=3, reverse=True) - log_1m
        a = jnp.where(strict, jnp.exp(jax.nn.log_sigmoid(z) + log_rest), 0.0)
        return jnp.einsum('bhqs,bshe->bqhe', a.astype(v.dtype), v)

    return _sweep(block, S)


def setup_inputs(seed: int = 0) -> dict:
    key = jax.random.key(seed)
    ks = jax.random.split(key, 20)
    f32 = jnp.float32

    def nrm(k, shape, scale):
        return jax.random.normal(k, shape, f32) * scale

    def gain(k, shape):
        return 1.0 + 0.02 * jax.random.normal(k, shape, f32)

    x = jax.random.normal(ks[0], (BATCH, SEQ, D_MODEL), f32)
    offs = jax.random.randint(ks[1], (BATCH, 1), 0, 4096, dtype=jnp.int32)
    positions = (jnp.arange(SEQ, dtype=jnp.int32)[None, :] + offs).astype(jnp.int32)
    return {
        'x': x,
        'positions': positions,
        'norm_g': gain(ks[2], (DEPTH, D_MODEL)),
        'w_in': nrm(ks[3], (DEPTH, D_MODEL, D_IN), D_MODEL ** -0.5),
        'kv_norm_g': gain(ks[4], (DEPTH, KV_RANK)),
        'w_kv_up': nrm(ks[5], (DEPTH, KV_RANK, 2 * HEAD_DIM), KV_RANK ** -0.5),
        'q_norm_a': gain(ks[6], (DEPTH, HEAD_DIM)),
        'k_norm_a': gain(ks[7], (DEPTH, HEAD_DIM)),
        'ret_norm_g': gain(ks[8], (DEPTH, GROUP_WIDTH)),
        'q_norm_c': gain(ks[9], (DEPTH, DIFF_HALF)),
        'k_norm_c': gain(ks[10], (DEPTH, DIFF_HALF)),
        'lam_q1': nrm(ks[11], (DEPTH, DIFF_HALF), 0.1),
        'lam_k1': nrm(ks[12], (DEPTH, DIFF_HALF), 0.1),
        'lam_q2': nrm(ks[13], (DEPTH, DIFF_HALF), 0.1),
        'lam_k2': nrm(ks[14], (DEPTH, DIFF_HALF), 0.1),
        'subln_g': gain(ks[15], (DEPTH, HEAD_DIM)),
        'w_out': nrm(ks[16], (DEPTH, D_MIX, D_MODEL), D_MIX ** -0.5),
    }


def reference(x, positions, norm_g, w_in, kv_norm_g, w_kv_up, q_norm_a, k_norm_a, ret_norm_g,
              q_norm_c, k_norm_c, lam_q1, lam_k1, lam_q2, lam_k2, subln_g, w_out):
    B, S, _ = x.shape

    def heads(t, d):
        return t.reshape(B, S, -1, d)

    for l in range(DEPTH):
        h = _rms(x, norm_g[l])
        proj = jnp.einsum('bsd,df->bsf', h, w_in[l])
        (qa, ckv, qidx, kidx, widx, ga,
         qb, kb, vb, gb,
         qc, kc, vc, gc,
         qd, kd, vd, gd) = _split(proj, IN_SIZES)

        kv_a = jnp.einsum('bsr,rf->bsf', _rms(ckv, kv_norm_g[l]), w_kv_up[l])
        k_a, v_a = kv_a[..., :HEAD_DIM], kv_a[..., HEAD_DIM:]
        q_a = _rope(_rms(heads(qa, HEAD_DIM), q_norm_a[l]), positions, ROPE_THETA, HEAD_DIM // 4)
        k_a = _rope(_rms(k_a, k_norm_a[l])[:, :, None, :], positions, ROPE_THETA, HEAD_DIM // 4)[:, :, 0, :]
        q_i = _rope(heads(qidx, IDX_DIM), positions, ROPE_THETA, IDX_DIM // 4)
        k_i = _rope(_rms(kidx)[:, :, None, :], positions, ROPE_THETA, IDX_DIM // 4)[:, :, 0, :]
        y_a = _dsa(q_a, k_a, v_a, q_i, k_i, widx).reshape(B, S, GROUP_WIDTH)

        q_b = _rope(heads(qb, HEAD_DIM), positions, RET_THETA, HEAD_DIM)
        k_b = _rope(heads(kb, HEAD_DIM), positions, RET_THETA, HEAD_DIM)
        y_b = _retention(q_b, k_b, heads(vb, HEAD_DIM), ret_norm_g[l])

        qc4 = heads(qc, 2 * DIFF_HALF)
        kc4 = heads(kc, 2 * DIFF_HALF)
        prep_q = lambda t: _rope(_rms(t, q_norm_c[l]), positions, ROPE_THETA, DIFF_HALF // 4)
        prep_k = lambda t: _rope(_rms(t, k_norm_c[l]), positions, ROPE_THETA, DIFF_HALF // 4)
        q1, q2 = prep_q(qc4[..., :DIFF_HALF]), prep_q(qc4[..., DIFF_HALF:])
        k1, k2 = prep_k(kc4[..., :DIFF_HALF]), prep_k(kc4[..., DIFF_HALF:])
        lam_init = 0.8 - 0.6 * math.exp(-0.3 * l)
        lam = (jnp.exp(jnp.sum(lam_q1[l].astype(jnp.float32) * lam_k1[l].astype(jnp.float32)))
               - jnp.exp(jnp.sum(lam_q2[l].astype(jnp.float32) * lam_k2[l].astype(jnp.float32)))
               + lam_init)
        y_c = _diff_attn(q1, q2, k1, k2, heads(vc, HEAD_DIM), lam)
        y_c = (_rms(y_c, subln_g[l]) * (1.0 - lam_init)).reshape(B, S, GROUP_WIDTH)

        y_d = _stick_breaking(heads(qd, HEAD_DIM), heads(kd, HEAD_DIM), heads(vd, HEAD_DIM)).reshape(B, S, GROUP_WIDTH)

        y = jnp.concatenate([
            y_a * jax.nn.silu(ga),
            y_b * jax.nn.silu(gb),
            y_c * jax.nn.silu(gc),
            y_d * jax.nn.silu(gd),
        ], axis=-1)
        x = x + jnp.einsum('bsf,fd->bsd', y, w_out[l])
    return x
```

```cpp
#include <hip/hip_runtime.h>
#include <hip/hip_cooperative_groups.h>
#include <cstdio>
#include <cstdint>
namespace cg = cooperative_groups;

#define DI __device__ __forceinline__
#define LAS __attribute__((address_space(3)))
typedef unsigned short u16;
typedef short bf16x8 __attribute__((ext_vector_type(8)));
typedef short s16x4 __attribute__((ext_vector_type(4)));
typedef float f32x16 __attribute__((ext_vector_type(16)));
typedef float f32x4 __attribute__((ext_vector_type(4)));
typedef float f32x2 __attribute__((ext_vector_type(2)));
typedef unsigned u32x4 __attribute__((ext_vector_type(4)));
typedef unsigned u32x2 __attribute__((ext_vector_type(2)));
typedef __bf16 bf16x2_t __attribute__((ext_vector_type(2)));
#define MFMA32(a, b, c) __builtin_amdgcn_mfma_f32_32x32x16_bf16((a), (b), (c), 0, 0, 0)

constexpr int NB = 8, S = 8192, DM = 1024, MTOK = NB * S, NP = 4352, DIN = 4296;
constexpr float EPS = 1e-6f;
constexpr float LOG2E = 1.4426950408889634f;
constexpr int C_QA = 0, C_KA = 256, C_VA = 320, C_QI = 384, C_KI = 896, C_GA = 960;
constexpr int C_QB = 1216, C_KB = 1472, C_VB = 1728, C_GB = 1984;
constexpr int C_QC = 2240, C_KC = 2496, C_VC = 2752, C_GC = 3008;
constexpr int C_QD = 3264, C_KD = 3520, C_VD = 3776, C_GD = 4032, C_WI = 4288;
constexpr size_t WS_CTL = 0, WS_RROW = 4096, WS_WIN = 1u << 20, WS_WOUT = WS_WIN + (size_t)2 * NP * DM * 2, WS_WKV = WS_WOUT + (size_t)2 * DM * DM * 2,
                 WS_RSS = (size_t)24 << 20  ,
                 WS_XB = (size_t)32 << 20, WS_PROJ = WS_XB + (size_t)MTOK * DM * 2, WS_XB2 = WS_PROJ + (size_t)MTOK * NP * 2, WS_KVC = WS_XB2 + (size_t)MTOK * DM * 2  ,
                 WS_KIC = WS_KVC + (size_t)MTOK * 128 * 2  , WS_END = WS_KIC + (size_t)MTOK * 64 * 2;
constexpr int LDS_BYTES = 143360;

struct Params {
  const float* x; const int* pos; const float* norm_g; const float* w_in; const float* kv_norm_g; const float* w_kv_up;
  const float* q_norm_a; const float* k_norm_a; const float* ret_norm_g; const float* q_norm_c; const float* k_norm_c;
  const float* lam_q1; const float* lam_k1; const float* lam_q2; const float* lam_k2; const float* subln_g; const float* w_out;
  float* out; unsigned char* ws;
};

DI unsigned pk2(float lo, float hi) { f32x2 x = {lo, hi}; return __builtin_bit_cast(unsigned, __builtin_convertvector(x, bf16x2_t)); }
DI float bflo(unsigned w) { return __uint_as_float(w << 16); }
DI float bfhi(unsigned w) { return __uint_as_float(w & 0xffff0000u); }
DI float bf2f(u16 v) { return __uint_as_float((unsigned)v << 16); }
DI u16 f2bf(float f) { return (u16)(pk2(f, 0.f) & 0xffffu); }
DI float fexp2(float x) { return __builtin_amdgcn_exp2f(x); }
DI float frcp(float x) { return __builtin_amdgcn_rcpf(x); }
DI float silu(float x) { return x * frcp(1.0f + fexp2(-x * LOG2E)); }
DI int crow(int i, int h) { return (i & 3) + 8 * (i >> 2) + 4 * h; }
DI bf16x8 pack8(const f32x16& x, int s) {
  u32x4 p; p[0] = pk2(x[8 * s], x[8 * s + 1]); p[1] = pk2(x[8 * s + 2], x[8 * s + 3]); p[2] = pk2(x[8 * s + 4], x[8 * s + 5]); p[3] = pk2(x[8 * s + 6], x[8 * s + 7]);
  return __builtin_bit_cast(bf16x8, p);
}
DI f32x16 zero16() { f32x16 z; for (int i = 0; i < 16; ++i) z[i] = 0.f; return z; }
DI float sum16(float v) { v += __shfl_xor(v, 8); v += __shfl_xor(v, 4); v += __shfl_xor(v, 2); v += __shfl_xor(v, 1); return v; }
DI float sum32(float v) { v += __shfl_xor(v, 16); return sum16(v); }
DI float sum64(float v) { v += __shfl_xor(v, 32); return sum32(v); }
DI float lam_init_of(int l) { return l == 0 ? 0.2f : 0.35550907f; }
DI float xsum16(float x) { const unsigned u = __float_as_uint(x); const auto r = __builtin_amdgcn_permlane16_swap(u, u, false, false); return __uint_as_float(r[0]) + __uint_as_float(r[1]); }
DI float xsum32(float x) { const unsigned u = __float_as_uint(x); const auto r = __builtin_amdgcn_permlane32_swap(u, u, false, false); return __uint_as_float(r[0]) + __uint_as_float(r[1]); }

namespace pg8 {
#define PG8_LAS __attribute__((address_space(3)))
typedef unsigned short bf16_t;
typedef short bf16x8 __attribute__((ext_vector_type(8)));
typedef float f32x4 __attribute__((ext_vector_type(4)));
typedef unsigned u32x4 __attribute__((ext_vector_type(4)));
constexpr int BM = 256, BK = 64, HALF = 128, HTB = HALF * BK * 2  , STAGE_BYTES = 8 * HTB, NXCD = 8, WGM = 8;

__host__ __device__ __forceinline__ int lds_byte(int r, int c) { const int st = (r >> 4) * 2 + (c >> 5), rr = r & 15, cc = c & 31, ob = rr * 64 + cc * 2; return st * 1024 + (ob ^ (((ob >> 9) & 1) << 5)); }
__host__ __device__ __forceinline__ void stage_rc(int b, int& R, int& C) { const int st = b / 1024, sb = b % 1024, swz = sb ^ (((sb >> 9) & 1) << 5); R = (st >> 1) * 16 + swz / 64; C = (st & 1) * 32 + (swz % 64) / 2; }
__host__ __device__ __forceinline__ int perm32(int rho) { const int n = rho >> 4, i = rho & 15; return 8 * (i >> 2) + 4 * n + (i & 3); }

struct Unit { int pm, pn; };
struct Gemm { const bf16_t* A; const bf16_t* Bt; int M, N, K; };

struct StaticOrder {
    int nM, nN, nwg, G, c;
    __host__ __device__ void init(int M, int N, int G_, int c_) { nM = M / BM; nN = N / BM; nwg = nM * nN; G = G_; c = c_; }
    __host__ __device__ bool next(int i, Unit& u) const {
        const long L = (long)i * G + c; if (L >= nwg) return false;
        int wgid = (int)L; { const int q = nwg / NXCD, r = nwg % NXCD, xcd = wgid % NXCD, off = wgid / NXCD; wgid = (xcd < r ? xcd * (q + 1) : r * (q + 1) + (xcd - r) * q) + off; }
        const int nig = WGM * nN, gid = wgid / nig, fm = gid * WGM, gsz = (nM - fm) < WGM ? (nM - fm) : WGM;
        u.pm = fm + ((wgid % nig) % gsz); u.pn = (wgid % nig) / gsz; return true;
    }
    __device__ __forceinline__ void a_ready(const Unit&) const {}
    __device__ __forceinline__ void done(const Unit&) const {}
};

struct EpiProj {
    static constexpr bool PERM = true, AFTER_DRAIN = false;
    u16* O; const float* rrow;
    __device__ __forceinline__ void operator()(const f32x4 (&acc)[2][2][4][2], const Unit& u, int wr, int wc, int fr, int fq) const {
        const int row0 = u.pm * BM + wr * 64 + fr; const int col0 = u.pn * BM + wc * 32 + 8 * fq;
#pragma unroll
        for (int ai = 0; ai < 2; ++ai)
#pragma unroll
            for (int m = 0; m < 4; ++m) { const int row = row0 + ai * HALF + m * 16; const float rs = rrow[row]; u16* rowp = O + (size_t)row * NP + col0;
#pragma unroll
                for (int bj = 0; bj < 2; ++bj) { const f32x4 v0 = acc[ai][bj][m][0] * rs, v1 = acc[ai][bj][m][1] * rs;
                    u32x4 w; w.x = pk2(v0[0], v0[1]); w.y = pk2(v0[2], v0[3]); w.z = pk2(v1[0], v1[1]); w.w = pk2(v1[2], v1[3]);
                    *(u32x4*)(rowp + bj * HALF) = w; } }
    }
};
struct EpiProj2 {
    static constexpr bool PERM = true, AFTER_DRAIN = false;
    u16* O; const float* rss;
    __device__ __forceinline__ void operator()(const f32x4 (&acc)[2][2][4][2], const Unit& u, int wr, int wc, int fr, int fq) const {
        const int row0 = u.pm * BM + wr * 64 + fr; const int col0 = u.pn * BM + wc * 32 + 8 * fq;
#pragma unroll
        for (int ai = 0; ai < 2; ++ai)
#pragma unroll
            for (int m = 0; m < 4; ++m) { const int row = row0 + ai * HALF + m * 16; const f32x4* pr = (const f32x4*)(rss + (size_t)row * 16);
                const f32x4 p0 = pr[0], p1 = pr[1], p2 = pr[2], p3 = pr[3]; const f32x4 ps = (p0 + p1) + (p2 + p3);
                const float rs = rsqrtf(((ps[0] + ps[1]) + (ps[2] + ps[3])) * (1.0f / DM) + EPS); u16* rowp = O + (size_t)row * NP + col0;
#pragma unroll
                for (int bj = 0; bj < 2; ++bj) { const f32x4 v0 = acc[ai][bj][m][0] * rs, v1 = acc[ai][bj][m][1] * rs;
                    u32x4 w; w.x = pk2(v0[0], v0[1]); w.y = pk2(v0[2], v0[3]); w.z = pk2(v1[0], v1[1]); w.w = pk2(v1[2], v1[3]);
                    *(u32x4*)(rowp + bj * HALF) = w; } }
    }
};
struct EpiResNext {
    static constexpr bool PERM = false, AFTER_DRAIN = false;
    const float* base; float* out; u16* xn; float* rss;
    __device__ __forceinline__ void operator()(const f32x4 (&acc)[2][2][4][2], const Unit& u, int wr, int wc, int fr, int fq) const {
        const int row0 = u.pm * BM + wr * 64 + fr; const int col0 = u.pn * BM + wc * 32 + 4 * fq;
#pragma unroll
        for (int ai = 0; ai < 2; ++ai)
#pragma unroll
            for (int m = 0; m < 4; ++m) { const int row = row0 + ai * HALF + m * 16; const size_t off = (size_t)row * DM + col0; float ss = 0.f;
#pragma unroll
                for (int bj = 0; bj < 2; ++bj)
#pragma unroll
                    for (int n = 0; n < 2; ++n) { const size_t o2 = off + bj * HALF + n * 16; const f32x4 o = *(const f32x4*)(base + o2) + acc[ai][bj][m][n]; *(f32x4*)(out + o2) = o;
                        u32x2 w; w.x = pk2(o[0], o[1]); w.y = pk2(o[2], o[3]); *(u32x2*)(xn + o2) = w; ss += (o[0] * o[0] + o[1] * o[1]) + (o[2] * o[2] + o[3] * o[3]); }
                ss += __shfl_xor(ss, 16); ss += __shfl_xor(ss, 32);
                if (fq == 0) rss[(size_t)row * 16 + u.pn * 4 + wc] = ss; }
    }
};
struct EpiRes {
    static constexpr bool PERM = false, AFTER_DRAIN = false;
    const float* base; float* out;
    __device__ __forceinline__ void operator()(const f32x4 (&acc)[2][2][4][2], const Unit& u, int wr, int wc, int fr, int fq) const {
        const int row0 = u.pm * BM + wr * 64 + fr; const int col0 = u.pn * BM + wc * 32 + 4 * fq;
#pragma unroll
        for (int ai = 0; ai < 2; ++ai)
#pragma unroll
            for (int m = 0; m < 4; ++m) { const size_t off = (size_t)(row0 + ai * HALF + m * 16) * DM + col0;
#pragma unroll
                for (int bj = 0; bj < 2; ++bj)
#pragma unroll
                    for (int n = 0; n < 2; ++n) { const size_t o2 = off + bj * HALF + n * 16; *(f32x4*)(out + o2) = *(const f32x4*)(base + o2) + acc[ai][bj][m][n]; } }
    }
};
template <class Epi, class Sched, bool ALIGN_EPI = false, bool SP2 = false>
__device__ __forceinline__ void gemm_phase(PG8_LAS unsigned char* lds, const Gemm g, const Sched& S, const Epi& E) {
    int tid_ = threadIdx.x; asm volatile("" : "+v"(tid_));
    const int tid = tid_, wid = __builtin_amdgcn_readfirstlane(tid >> 6), lane = tid & 63, wr = wid >> 2, wc = wid & 3, fr = lane & 15, fq = lane >> 4;
    const int K = g.K, nt = K / BK;
    unsigned voffA[2], voffB[2];
#pragma unroll
    for (int i = 0; i < 2; ++i) { int R, C; stage_rc(tid * 16 + i * 8192, R, C); const int Rb = Epi::PERM ? ((R & ~31) + perm32(R & 31)) : R;
        voffA[i] = (unsigned)(R * K + C) * 2u; voffB[i] = (unsigned)(Rb * K + C) * 2u; }
    const size_t kstep = (size_t)(BK * 2);
    const size_t hstep = (size_t)HALF * K * 2;
    const size_t tstep = 2 * hstep;
    const unsigned ldsw = (unsigned)wid * 1024u;
    const int aoff = lds_byte(wr * 64 + fr, fq * 8), boff = lds_byte(wc * 32 + fr, fq * 8);
#define PG8_SA(b, h) (((b) * 2 + (h)) * HTB)
#define PG8_SB(b, h) ((4 + (b) * 2 + (h)) * HTB)
#define PG8_STAGE(bufoff, gbase, voff) do { _Pragma("unroll") for (int _i = 0; _i < 2; ++_i) \
        __builtin_amdgcn_global_load_lds((const unsigned*)((const char*)(gbase) + (voff)[_i]), (PG8_LAS unsigned*)(lds + (bufoff) + ldsw + _i * 8192), 16, 0, 0); } while (0)
#define PG8_LDA(dst, b, h) do { _Pragma("unroll") for (int m = 0; m < 4; ++m) _Pragma("unroll") for (int k = 0; k < 2; ++k) dst[m][k] = *(const PG8_LAS bf16x8*)(lds + PG8_SA(b, h) + aoff + m * 2048 + k * 1024); } while (0)
#define PG8_LDB(dst, b, h) do { _Pragma("unroll") for (int n = 0; n < 2; ++n) _Pragma("unroll") for (int k = 0; k < 2; ++k) dst[n][k] = *(const PG8_LAS bf16x8*)(lds + PG8_SB(b, h) + boff + n * 2048 + k * 1024); } while (0)
#define PG8_MMA(ai, bj, At, Bt) do { __builtin_amdgcn_s_setprio(1); _Pragma("unroll") for (int m = 0; m < 4; ++m) _Pragma("unroll") for (int n = 0; n < 2; ++n) _Pragma("unroll") for (int k = 0; k < 2; ++k) \
        acc[ai][bj][m][n] = __builtin_amdgcn_mfma_f32_16x16x32_bf16(Bt[n][k], At[m][k], acc[ai][bj][m][n], 0, 0, 0); __builtin_amdgcn_s_setprio(0); } while (0)
#define PG8_WAIT_V(n) asm volatile("s_waitcnt vmcnt(" #n ")" ::: "memory")
#define PG8_WAIT_L(n) asm volatile("s_waitcnt lgkmcnt(" #n ")" ::: "memory")
#define PG8_BAR __builtin_amdgcn_s_barrier()
#define PG8_SCHED __builtin_amdgcn_sched_barrier(0)
    Unit cur, nxt; int ui = 0;
    if (!S.next(0, cur)) return;
    f32x4 acc[2][2][4][2];
#pragma unroll
    for (int a = 0; a < 2; ++a)
#pragma unroll
        for (int b = 0; b < 2; ++b)
#pragma unroll
            for (int m = 0; m < 4; ++m)
#pragma unroll
                for (int n = 0; n < 2; ++n) acc[a][b][m][n] = (f32x4){0.f, 0.f, 0.f, 0.f};
    bf16x8 At[4][2], B0[2][2], B1[2][2];
    const char* cA = (const char*)g.A + (size_t)cur.pm * tstep; const char* cB = (const char*)g.Bt + (size_t)cur.pn * tstep;
    S.a_ready(cur);
    if constexpr (SP2) {
        PG8_STAGE(PG8_SB(0, 0), cB, voffB); PG8_STAGE(PG8_SB(0, 1), cB + hstep, voffB); PG8_STAGE(PG8_SA(0, 0), cA, voffA); PG8_STAGE(PG8_SA(0, 1), cA + hstep, voffA);
        if (wr == 1) PG8_BAR;
        PG8_WAIT_V(2); PG8_BAR;
        PG8_STAGE(PG8_SB(1, 0), cB + kstep, voffB); PG8_STAGE(PG8_SA(1, 0), cA + kstep, voffA); PG8_STAGE(PG8_SB(1, 1), cB + hstep + kstep, voffB);
        PG8_WAIT_V(6); PG8_BAR;
    } else {
        PG8_STAGE(PG8_SB(0, 0), cB, voffB); PG8_STAGE(PG8_SA(0, 0), cA, voffA); PG8_STAGE(PG8_SB(0, 1), cB + hstep, voffB); PG8_STAGE(PG8_SA(0, 1), cA + hstep, voffA);
        if (wr == 1) PG8_BAR;
        PG8_WAIT_V(4); PG8_BAR;
        PG8_STAGE(PG8_SB(1, 0), cB + kstep, voffB); PG8_STAGE(PG8_SA(1, 0), cA + kstep, voffA); PG8_STAGE(PG8_SB(1, 1), cB + hstep + kstep, voffB);
        PG8_WAIT_V(6); PG8_BAR;
    }
    for (;;) {
        const bool has_next = S.next(ui + 1, nxt);
        const char* nA = has_next ? (const char*)g.A + (size_t)nxt.pm * tstep : cA; const char* nB = has_next ? (const char*)g.Bt + (size_t)nxt.pn * tstep : cB;
        for (int t = 0; t < nt; t += 2) {
            const bool last = (t == nt - 2);
            const char* a1 = cA + (size_t)(t + 1) * kstep;
            const char* a2 = last ? nA : cA + (size_t)(t + 2) * kstep; const char* b2 = last ? nB : cB + (size_t)(t + 2) * kstep;
            const char* a3 = a2 + kstep; const char* b3 = b2 + kstep;
            if (last && has_next) S.a_ready(nxt);
            if constexpr (SP2) {
            PG8_LDB(B0, 0, 0); PG8_LDB(B1, 0, 1); PG8_SCHED; PG8_LDA(At, 0, 0); PG8_STAGE(PG8_SA(1, 1), a1 + hstep, voffA);
            PG8_WAIT_V(8); PG8_WAIT_L(0); PG8_BAR; PG8_MMA(0, 0, At, B0); PG8_MMA(0, 1, At, B1); PG8_BAR; PG8_SCHED;
            PG8_LDA(At, 0, 1); PG8_STAGE(PG8_SB(0, 0), b2, voffB); PG8_STAGE(PG8_SB(0, 1), b2 + hstep, voffB); PG8_STAGE(PG8_SA(0, 0), a2, voffA);
            PG8_WAIT_V(8); PG8_WAIT_L(0); PG8_BAR; PG8_MMA(1, 0, At, B0); PG8_MMA(1, 1, At, B1); PG8_BAR; PG8_SCHED;
            PG8_LDB(B0, 1, 0); PG8_LDB(B1, 1, 1); PG8_SCHED; PG8_LDA(At, 1, 0); PG8_STAGE(PG8_SA(0, 1), a2 + hstep, voffA);
            PG8_WAIT_V(8); PG8_WAIT_L(0); PG8_BAR; PG8_MMA(0, 0, At, B0); PG8_MMA(0, 1, At, B1); PG8_BAR; PG8_SCHED;
            PG8_LDA(At, 1, 1); PG8_STAGE(PG8_SB(1, 0), b3, voffB); PG8_STAGE(PG8_SB(1, 1), b3 + hstep, voffB); PG8_STAGE(PG8_SA(1, 0), a3, voffA);
            PG8_WAIT_V(8); PG8_WAIT_L(0); PG8_BAR; PG8_MMA(1, 0, At, B0); PG8_MMA(1, 1, At, B1); PG8_BAR; PG8_SCHED;
            } else {
            PG8_LDB(B0, 0, 0); PG8_SCHED; PG8_LDA(At, 0, 0); PG8_STAGE(PG8_SA(1, 1), a1 + hstep, voffA);
            PG8_WAIT_L(8); PG8_BAR; PG8_WAIT_L(0); PG8_MMA(0, 0, At, B0); PG8_BAR; PG8_SCHED;
            PG8_LDB(B1, 0, 1); PG8_STAGE(PG8_SB(0, 0), b2, voffB);
            PG8_BAR; PG8_WAIT_L(0); PG8_MMA(0, 1, At, B1); PG8_BAR;
            PG8_LDA(At, 0, 1); PG8_STAGE(PG8_SA(0, 0), a2, voffA);
            PG8_BAR; PG8_WAIT_L(0); PG8_MMA(1, 0, At, B0); PG8_BAR; PG8_SCHED;
            PG8_STAGE(PG8_SB(0, 1), b2 + hstep, voffB);
            PG8_WAIT_V(6); PG8_BAR; PG8_MMA(1, 1, At, B1); PG8_BAR;
            PG8_LDB(B0, 1, 0); PG8_SCHED; PG8_LDA(At, 1, 0); PG8_STAGE(PG8_SA(0, 1), a2 + hstep, voffA);
            PG8_WAIT_L(8); PG8_BAR; PG8_WAIT_L(0); PG8_MMA(0, 0, At, B0); PG8_BAR; PG8_SCHED;
            PG8_LDB(B1, 1, 1); PG8_STAGE(PG8_SB(1, 0), b3, voffB);
            PG8_BAR; PG8_WAIT_L(0); PG8_MMA(0, 1, At, B1); PG8_BAR;
            PG8_LDA(At, 1, 1); PG8_STAGE(PG8_SA(1, 0), a3, voffA);
            PG8_BAR; PG8_WAIT_L(0); PG8_MMA(1, 0, At, B0); PG8_BAR; PG8_SCHED;
            PG8_STAGE(PG8_SB(1, 1), b3 + hstep, voffB);
            PG8_WAIT_V(6); PG8_BAR; PG8_MMA(1, 1, At, B1); PG8_BAR;
            }
        }
        if constexpr (ALIGN_EPI) { if (wr == 0) PG8_BAR; }
        if constexpr (!Epi::AFTER_DRAIN) { E(acc, cur, wr, wc, fr, fq); S.done(cur); }
        if (!has_next) break;
#pragma unroll
        for (int a = 0; a < 2; ++a)
#pragma unroll
            for (int b = 0; b < 2; ++b)
#pragma unroll
                for (int m = 0; m < 4; ++m)
#pragma unroll
                    for (int n = 0; n < 2; ++n) acc[a][b][m][n] = (f32x4){0.f, 0.f, 0.f, 0.f};
        cur = nxt; cA = nA; cB = nB; ++ui;
        if constexpr (ALIGN_EPI) { if (wr == 1) PG8_BAR; }
    }
    PG8_WAIT_V(0);
    if constexpr (!ALIGN_EPI) { if (wr == 0) PG8_BAR; }
    PG8_BAR;
    if constexpr (Epi::AFTER_DRAIN) { E.fused(acc, cur, wr, wc, fr, fq, lds, wid, lane); S.done(cur); }
#undef PG8_SA
#undef PG8_SB
#undef PG8_STAGE
#undef PG8_LDA
#undef PG8_LDB
#undef PG8_MMA
#undef PG8_WAIT_V
#undef PG8_WAIT_L
#undef PG8_BAR
#undef PG8_SCHED
}
}
template <int MAP> DI void wtile(LAS float* T, const float* src, int ld_src, const float* g, u16* dst, int Kdim, int n0, int k0) {
  int tid_ = threadIdx.x; asm volatile("" : "+v"(tid_)); const int tid = tid_;
#pragma unroll
  for (int i = 0; i < 8; ++i) {
    const int idx = tid + 512 * i, kk = idx >> 6, nn = idx & 63; int c = n0 + nn;
    if (MAP == 1) { c = c < 960 ? c : (c < 4288 ? c + 8 : (c < 4296 ? 960 + (c - 4288) : -1)); }
    float v = 0.f;
    if (c >= 0) { v = src[(size_t)(k0 + kk) * ld_src + c]; if (g) v *= g[k0 + kk]; if (MAP == 1 && n0 + nn >= C_QD && n0 + nn < C_QD + 256) v *= LOG2E * 0.125f; }
    T[nn * 65 + kk] = v;
  }
  __syncthreads();
#pragma unroll
  for (int i = 0; i < 8; ++i) { const int idx = tid + 512 * i, nn = idx >> 6, kk = idx & 63; dst[(size_t)(n0 + nn) * Kdim + k0 + kk] = f2bf(T[nn * 65 + kk]); }
  __syncthreads();
}
DI void prep_weights(const Params& p, LAS unsigned char* lds) {
  LAS float* T = (LAS float*)lds;
  constexpr int U_IN = (NP / 64) * (DM / 64), U_OUT = (DM / 64) * (DM / 64), U_KV = 4, U_L = U_IN + U_OUT + U_KV;
  for (int u = blockIdx.x; u < 2 * U_L; u += gridDim.x) {
    const int l = u / U_L; int r = u % U_L;
    if (r < U_IN) { wtile<1>(T, p.w_in + (size_t)l * DM * DIN, DIN, p.norm_g + l * DM, (u16*)(p.ws + WS_WIN) + (size_t)l * NP * DM, DM, (r / 16) * 64, (r % 16) * 64); }
    else if (r < U_IN + U_OUT) { r -= U_IN; wtile<0>(T, p.w_out + (size_t)l * DM * DM, DM, nullptr, (u16*)(p.ws + WS_WOUT) + (size_t)l * DM * DM, DM, (r / 16) * 64, (r % 16) * 64); }
    else { r -= U_IN + U_OUT; wtile<0>(T, p.w_kv_up + (size_t)l * 128 * 128, 128, p.kv_norm_g + l * 128, (u16*)(p.ws + WS_WKV) + (size_t)l * 128 * 128, 128, (r / 2) * 64, (r % 2) * 64); }
  }
}
DI void prep_x(const Params& p, const float* src) {
  int tid_ = threadIdx.x; asm volatile("" : "+v"(tid_)); const int lane = tid_ & 63, w = tid_ >> 6;
  u16* xb = (u16*)(p.ws + WS_XB); float* rrow = (float*)(p.ws + WS_RROW);
#pragma unroll 4
  for (int row = blockIdx.x * 8 + w; row < MTOK; row += gridDim.x * 8) {
    const float* xr = src + (size_t)row * DM; f32x4 v[4]; float ss = 0.f;
#pragma unroll
    for (int i = 0; i < 4; ++i) { v[i] = *(const f32x4*)(xr + lane * 4 + 256 * i); ss += v[i][0] * v[i][0] + v[i][1] * v[i][1] + v[i][2] * v[i][2] + v[i][3] * v[i][3]; }
    ss = sum64(ss);
#pragma unroll
    for (int i = 0; i < 4; ++i) { u32x2 o; o.x = pk2(v[i][0], v[i][1]); o.y = pk2(v[i][2], v[i][3]); *(u32x2*)(xb + (size_t)row * DM + lane * 4 + 256 * i) = o; }
    if (lane == 0) rrow[row] = rsqrtf(ss * (1.0f / DM) + EPS);
  }
}

template <int HP> DI void rope2(f32x2& x, int hl, const LAS f32x2* cs) {
  const float pa = __shfl_xor(x[0], HP), pb = __shfl_xor(x[1], HP);
  if (hl < HP) { const f32x2 c0 = cs[2 * hl], c1 = cs[2 * hl + 1]; x[0] = x[0] * c0[0] - pa * c0[1]; x[1] = x[1] * c1[0] - pb * c1[1]; }
  else if (hl < 2 * HP) { const f32x2 c0 = cs[2 * (hl - HP)], c1 = cs[2 * (hl - HP) + 1]; x[0] = x[0] * c0[0] + pa * c0[1]; x[1] = x[1] * c1[0] + pb * c1[1]; }
}
DI f32x2 unpk(unsigned w) { f32x2 r = {bflo(w), bfhi(w)}; return r; }

DI void post_unit(const Params& p, int l, int unit, LAS unsigned char* lds) {
  int tid_ = threadIdx.x; asm volatile("" : "+v"(tid_)); const int tid = tid_, lane = tid & 63, w = tid >> 6, hl = lane & 31, hsel = lane >> 5, hl16 = lane & 15;
  const int b = unit >> 7, n = unit & 127; const size_t tok0 = (size_t)b * S + n * 64;
  u16* proj = (u16*)(p.ws + WS_PROJ);
  LAS f32x2* cs16 = (LAS f32x2*)lds;
  LAS f32x2* cs8 = (LAS f32x2*)(lds + 4096);
  LAS f32x2* cs64 = (LAS f32x2*)(lds + 6144);
  LAS unsigned char* At = lds + 22528;
  for (int idx = tid; idx < 64 * 44; idx += 512) {
    const int t = idx / 44, a = idx % 44; const float pos = (float)p.pos[tok0 + t];
    float inv; LAS f32x2* dst;
    if (a < 8) { inv = powf(500000.0f, -(float)a * 2.0f / 16.0f); dst = cs16 + t * 8 + a; }
    else if (a < 12) { inv = powf(500000.0f, -(float)(a - 8) * 2.0f / 8.0f); dst = cs8 + t * 4 + (a - 8); }
    else { inv = powf(10000.0f, -(float)(a - 12) * 2.0f / 64.0f); dst = cs64 + t * 32 + (a - 12); }
    const float ang = pos * inv; const float kq = rintf(ang * 0.15915494309189535f);
    float rr = fmaf(-kq, 6.28125f, ang); rr = fmaf(-kq, 1.9353071795864769e-3f, rr);
    const float sn = sinf(rr), cs_ = cosf(rr);
    f32x2 v = {cs_, sn}; *dst = v;
  }
  __syncthreads();
  const float* qna = p.q_norm_a + l * 64; const float* qnc = p.q_norm_c + l * 32; const float* knc = p.k_norm_c + l * 32;
  for (int tt = 0; tt < 8; ++tt) {
    const int t = w * 8 + tt; u16* row = proj + (tok0 + t) * NP;
    constexpr int segcol[16] = {C_QA, C_QA + 128, C_KA, C_QI, C_QI + 128, C_QI + 256, C_QI + 384, C_KI, C_QB, C_QB + 128, C_KB, C_KB + 128, C_QC, C_QC + 128, C_KC, C_KC + 128};
    unsigned raw[16];
#pragma unroll
    for (int s = 0; s < 16; ++s) raw[s] = *(const unsigned*)(row + segcol[s] + 2 * lane);
#pragma unroll
    for (int s = 0; s < 16; ++s) {
      f32x2 x = unpk(raw[s]); u16* pp = row + segcol[s] + 2 * lane;
      if (s < 2) {
        const float rs = rsqrtf(sum32(x[0] * x[0] + x[1] * x[1]) * (1.0f / 64.0f) + EPS);
        x[0] *= rs * qna[2 * hl]; x[1] *= rs * qna[2 * hl + 1]; rope2<4>(x, hl, cs16 + t * 8);
        x *= LOG2E * 0.125f; *(unsigned*)pp = pk2(x[0], x[1]);
      } else if (s == 2) {
        const float rs = rsqrtf(sum64(x[0] * x[0] + x[1] * x[1]) * (1.0f / 128.0f) + EPS);
        *(LAS unsigned*)(At + t * 272 + lane * 4) = pk2(x[0] * rs, x[1] * rs);
      } else if (s < 7) {
        rope2<4>(x, hl, cs16 + t * 8); *(unsigned*)pp = pk2(x[0], x[1]);
      } else if (s == 7) {
        const float rs = rsqrtf(sum32(x[0] * x[0] + x[1] * x[1]) * (1.0f / 64.0f) + EPS);
        x *= rs; rope2<4>(x, hl, cs16 + t * 8); if (lane < 32) *(unsigned*)((u16*)(p.ws + WS_KIC) + (tok0 + t) * 64 + 2 * lane) = pk2(x[0], x[1]);
      } else if (s < 12) {
        rope2<16>(x, hl, cs64 + t * 32);
        const int hd = ((s & 1) ? 2 : 0) + hsel;
        const float lg = log1pf(-exp2f(-5.0f - (float)hd));
        const float f = (s < 10) ? expf(lg * (float)(t + 1)) : expf(lg * (float)(63 - t)) * 0.125f;
        x *= f; *(unsigned*)pp = pk2(x[0], x[1]);
      } else {
        const float* gn = (s < 14) ? qnc : knc;
        const float rs = rsqrtf(sum16(x[0] * x[0] + x[1] * x[1]) * (1.0f / 32.0f) + EPS);
        x[0] *= rs * gn[2 * hl16]; x[1] *= rs * gn[2 * hl16 + 1]; rope2<2>(x, hl16, cs8 + t * 4);
        if (s < 14) x *= LOG2E * 0.17677669529663687f;
        *(unsigned*)pp = pk2(x[0], x[1]);
      }
    }
  }
  __syncthreads();
  if (w < 4) {
    const int tn = w & 1, part = w >> 1, r = lane & 31, h = lane >> 5;
    const u16* wkv = (const u16*)(p.ws + WS_WKV) + (size_t)l * 128 * 128;
    f32x16 c[2] = {zero16(), zero16()};
#pragma unroll
    for (int s = 0; s < 8; ++s) {
      const bf16x8 bfr = *(const LAS bf16x8*)(At + (32 * tn + r) * 272 + (16 * s + 8 * h) * 2);
#pragma unroll
      for (int mt = 0; mt < 2; ++mt) { const bf16x8 afr = *(const bf16x8*)(wkv + (size_t)(part * 64 + 32 * mt + r) * 128 + 16 * s + 8 * h); c[mt] = MFMA32(afr, bfr, c[mt]); }
    }
    const int t = 32 * tn + r; u16* row = proj + (tok0 + t) * NP;
    if (part == 0) {
      float ss = 0.f;
#pragma unroll
      for (int mt = 0; mt < 2; ++mt)
#pragma unroll
        for (int i = 0; i < 16; ++i) ss += c[mt][i] * c[mt][i];
      ss += __shfl_xor(ss, 32);
      const float rs = rsqrtf(ss * (1.0f / 64.0f) + EPS); const float* kna = p.k_norm_a + l * 64;
#pragma unroll
      for (int mt = 0; mt < 2; ++mt)
#pragma unroll
        for (int i = 0; i < 16; ++i) c[mt][i] *= rs * kna[32 * mt + crow(i, h)];
#pragma unroll
      for (int j = 0; j < 4; ++j) { const f32x2 cv = cs16[t * 8 + 4 * h + j]; const float x1 = c[0][j], x2 = c[0][4 + j]; c[0][j] = x1 * cv[0] - x2 * cv[1]; c[0][4 + j] = x2 * cv[0] + x1 * cv[1]; }
    }
    u16* dst = (u16*)(p.ws + WS_KVC) + (tok0 + t) * 128 + (part == 0 ? 0 : 64);
#pragma unroll
    for (int mt = 0; mt < 2; ++mt)
#pragma unroll
      for (int g = 0; g < 4; ++g) { u32x2 o; o.x = pk2(c[mt][4 * g], c[mt][4 * g + 1]); o.y = pk2(c[mt][4 * g + 2], c[mt][4 * g + 3]); *(u32x2*)(dst + 32 * mt + 8 * g + 4 * h) = o; }
  }
  __syncthreads();
}
constexpr int D_RS = 528;
constexpr int D_TILE = 64 * D_RS;
constexpr int D_KOFF = 0, D_VOFF = 2 * D_TILE, D_FLAG = 4 * D_TILE;

DI bf16x8 vfrag(LAS unsigned char* vt, int key0, int ecol, int lane) {
  const int q4 = (lane & 15) >> 2, p4 = lane & 3, blk = (lane >> 4) & 1;
  LAS unsigned char* a = vt + (key0 + q4) * D_RS + (ecol + 16 * blk + 4 * p4) * 2;
  const s16x4 lo = __builtin_amdgcn_ds_read_tr16_b64_v4i16((LAS s16x4*)a);
  const s16x4 hi = __builtin_amdgcn_ds_read_tr16_b64_v4i16((LAS s16x4*)(a + 8 * D_RS));
  return __builtin_shufflevector(lo, hi, 0, 1, 2, 3, 4, 5, 6, 7);
}

template <int MODE>
DI void dense_unit(const Params& p, int l, int b, int n, LAS unsigned char* lds) {
  constexpr int QCOL = MODE == 0 ? C_QC : (MODE == 1 ? C_QB : C_QD), KCOL = MODE == 0 ? C_KC : (MODE == 1 ? C_KB : C_KD);
  constexpr int VCOL = MODE == 0 ? C_VC : (MODE == 1 ? C_VB : C_VD), GCOL = MODE == 0 ? C_GC : (MODE == 1 ? C_GB : C_GD);
  constexpr int YCOL = MODE == 0 ? 512 : (MODE == 1 ? 256 : 768);
  int tid_ = threadIdx.x; asm volatile("" : "+v"(tid_)); const int tid = tid_, lane = tid & 63, w = tid >> 6, r = lane & 31, h = lane >> 5, hd = w >> 1, qh = w & 1;
  const u16* proj = (const u16*)(p.ws + WS_PROJ); u16* ybuf = (u16*)(p.ws + WS_XB);
  const size_t tq = (size_t)b * S + n * 64 + qh * 32 + r;
  const int iq = qh * 32 + r;
  bf16x8 qf[4];
#pragma unroll
  for (int s = 0; s < 4; ++s) qf[s] = *(const bf16x8*)(proj + tq * NP + QCOL + hd * 64 + 16 * s + 8 * h);
  LAS int* flag = (LAS int*)(lds + D_FLAG);
  const int ntiles = n + 1;
  u32x4 kr[4], vr[4];
  {
    const int m0 = (MODE == 2) ? n : 0; const u16* base = proj + ((size_t)b * S + m0 * 64) * NP;
#pragma unroll
    for (int i = 0; i < 4; ++i) { const int c = tid + 512 * i, row = c >> 5, c16 = c & 31; kr[i] = *(const u32x4*)(base + (size_t)row * NP + KCOL + c16 * 8); vr[i] = *(const u32x4*)(base + (size_t)row * NP + VCOL + c16 * 8); }
#pragma unroll
    for (int i = 0; i < 4; ++i) { const int c = tid + 512 * i, row = c >> 5, c16 = c & 31; *(LAS u32x4*)(lds + D_KOFF + row * D_RS + c16 * 16) = kr[i]; *(LAS u32x4*)(lds + D_VOFF + row * D_RS + c16 * 16) = vr[i]; }
    if (tid < 3) flag[tid] = 0;
  }
  __syncthreads();
  f32x16 o1[2] = {zero16(), zero16()}, o2[2] = {zero16(), zero16()};
  float l1 = 0.f, l2 = 0.f, carry = 1.0f;
  const float lg2g = log2f(1.0f - exp2f(-5.0f - (float)hd));
  const float cd = exp2f(lg2g * 64.0f);
  (void)l2; (void)carry; (void)cd; (void)lg2g; (void)iq;
#pragma unroll 1
  for (int it = 0; it < ntiles; ++it) {
    const int m = (MODE == 2) ? n - it : it, buf = it & 1; const bool has_next = it + 1 < ntiles;
    if (has_next) {
      const int mn = (MODE == 2) ? m - 1 : m + 1; const u16* base = proj + ((size_t)b * S + mn * 64) * NP;
#pragma unroll
      for (int i = 0; i < 4; ++i) { const int c = tid + 512 * i, row = c >> 5, c16 = c & 31; kr[i] = *(const u32x4*)(base + (size_t)row * NP + KCOL + c16 * 8); vr[i] = *(const u32x4*)(base + (size_t)row * NP + VCOL + c16 * 8); }
    }
    LAS unsigned char* kt = lds + D_KOFF + buf * D_TILE; LAS unsigned char* vt = lds + D_VOFF + buf * D_TILE;
    const bool diag = (m == n);
    if (MODE == 1) { if (it >= 1 && !diag) { o1[0] *= cd; o1[1] *= cd; } }
#pragma unroll
    for (int mi = 0; mi < 2; ++mi) {
      const int mt = (MODE == 2) ? 1 - mi : mi;
      LAS unsigned char* krow = kt + (32 * mt + r) * D_RS + (hd * 64 + 8 * h) * 2;
      const bf16x8 a0 = *(const LAS bf16x8*)(krow), a1 = *(const LAS bf16x8*)(krow + 32), a2 = *(const LAS bf16x8*)(krow + 64), a3 = *(const LAS bf16x8*)(krow + 96);
      if (MODE == 0) {
        f32x16 s1 = zero16(), s2 = zero16();
        s1 = MFMA32(a0, qf[0], s1); s1 = MFMA32(a1, qf[1], s1); s2 = MFMA32(a2, qf[2], s2); s2 = MFMA32(a3, qf[3], s2);
#pragma unroll
        for (int i = 0; i < 16; ++i) { s1[i] = fexp2(s1[i]); l1 += s1[i]; s2[i] = fexp2(s2[i]); l2 += s2[i]; }
#pragma unroll
        for (int s = 0; s < 2; ++s) {
          const bf16x8 p1 = pack8(s1, s), p2 = pack8(s2, s);
#pragma unroll
          for (int et = 0; et < 2; ++et) { const bf16x8 vf = vfrag(vt, 32 * mt + 16 * s + 4 * h, hd * 64 + 32 * et, lane); o1[et] = MFMA32(vf, p1, o1[et]); o2[et] = MFMA32(vf, p2, o2[et]); }
        }
      } else {
        f32x16 sc = zero16();
        sc = MFMA32(a0, qf[0], sc); sc = MFMA32(a1, qf[1], sc); sc = MFMA32(a2, qf[2], sc); sc = MFMA32(a3, qf[3], sc);
        if (MODE == 1) {
          if (diag) {
#pragma unroll
            for (int i = 0; i < 16; ++i) { const int jk = 32 * mt + crow(i, h); const float e = (jk <= iq) ? -64.0f : (float)(2 * (jk - iq) - 64); sc[i] *= fexp2(lg2g * e); }
          }
        } else {
          float rr[16];
#pragma unroll
          for (int i = 0; i < 16; ++i) { const float u = fexp2(sc[i]); float q = frcp(1.0f + u); if (diag) { const int jk = 32 * mt + crow(i, h); if (jk >= iq) q = 1.0f; } rr[i] = q; }
          float T[4], P2[4], P1[4];
#pragma unroll
          for (int g = 0; g < 4; ++g) { P2[g] = rr[4 * g + 3] * rr[4 * g + 2]; P1[g] = P2[g] * rr[4 * g + 1]; T[g] = P1[g] * rr[4 * g]; }
          float To[4], W[4];
#pragma unroll
          for (int g = 0; g < 4; ++g) { To[g] = __shfl_xor(T[g], 32); W[g] = T[g] * To[g]; }
          float suf[4]; suf[3] = 1.0f; suf[2] = W[3]; suf[1] = W[3] * W[2]; suf[0] = suf[1] * W[1];
          const float total = suf[0] * W[0];
#pragma unroll
          for (int g = 0; g < 4; ++g) {
            const float bs = carry * suf[g] * (h == 0 ? To[g] : 1.0f);
            sc[4 * g + 3] = (1.0f - rr[4 * g + 3]) * bs;
            sc[4 * g + 2] = (1.0f - rr[4 * g + 2]) * (bs * rr[4 * g + 3]);
            sc[4 * g + 1] = (1.0f - rr[4 * g + 1]) * (bs * P2[g]);
            sc[4 * g + 0] = (1.0f - rr[4 * g + 0]) * (bs * P1[g]);
          }
          carry *= total;
        }
#pragma unroll
        for (int s = 0; s < 2; ++s) {
          const bf16x8 p1 = pack8(sc, s);
#pragma unroll
          for (int et = 0; et < 2; ++et) { const bf16x8 vf = vfrag(vt, 32 * mt + 16 * s + 4 * h, hd * 64 + 32 * et, lane); o1[et] = MFMA32(vf, p1, o1[et]); }
        }
      }
    }
    if (has_next) {
      LAS unsigned char* kn = lds + D_KOFF + (buf ^ 1) * D_TILE; LAS unsigned char* vn = lds + D_VOFF + (buf ^ 1) * D_TILE;
#pragma unroll
      for (int i = 0; i < 4; ++i) { const int c = tid + 512 * i, row = c >> 5, c16 = c & 31; *(LAS u32x4*)(kn + row * D_RS + c16 * 16) = kr[i]; *(LAS u32x4*)(vn + row * D_RS + c16 * 16) = vr[i]; }
    }
    if (MODE == 2) {
      const int f3 = it % 3;
      if (__ballot(carry != 0.0f) != 0ull && lane == 0) flag[f3] = 1;
      if (tid == 0) flag[(it + 1) % 3] = 0;
      __syncthreads();
      if (flag[f3] == 0) break;
    } else {
      __syncthreads();
    }
  }
  float y[2][16];
  if (MODE == 0) {
    l1 += __shfl_xor(l1, 32); l2 += __shfl_xor(l2, 32);
    float s1 = 0.f, s2 = 0.f, s3 = 0.f, s4 = 0.f;
    for (int i = lane; i < 32; i += 64) { s1 += p.lam_q1[l * 32 + i] * p.lam_k1[l * 32 + i]; s2 += p.lam_q2[l * 32 + i] * p.lam_k2[l * 32 + i]; }
    s1 = sum64(s1); s2 = sum64(s2); (void)s3; (void)s4;
    const float li = lam_init_of(l), lam = expf(s1) - expf(s2) + li;
    const float i1 = 1.0f / l1, i2 = lam / l2; float ss = 0.f;
#pragma unroll
    for (int et = 0; et < 2; ++et)
#pragma unroll
      for (int i = 0; i < 16; ++i) { y[et][i] = o1[et][i] * i1 - o2[et][i] * i2; ss += y[et][i] * y[et][i]; }
    ss += __shfl_xor(ss, 32);
    const float rn = rsqrtf(ss * (1.0f / 64.0f) + EPS) * (1.0f - li);
#pragma unroll
    for (int et = 0; et < 2; ++et)
#pragma unroll
      for (int i = 0; i < 16; ++i) y[et][i] *= rn * p.subln_g[l * 64 + 32 * et + crow(i, h)];
  } else if (MODE == 1) {
    float sm = 0.f;
#pragma unroll
    for (int et = 0; et < 2; ++et)
#pragma unroll
      for (int i = 0; i < 16; ++i) sm += o1[et][i];
    sm += __shfl_xor(sm, 32); const float mu = sm * (1.0f / 64.0f); float sv = 0.f;
#pragma unroll
    for (int et = 0; et < 2; ++et)
#pragma unroll
      for (int i = 0; i < 16; ++i) { y[et][i] = o1[et][i] - mu; sv += y[et][i] * y[et][i]; }
    sv += __shfl_xor(sv, 32); const float rn = rsqrtf(sv * (1.0f / 64.0f) + EPS);
#pragma unroll
    for (int et = 0; et < 2; ++et)
#pragma unroll
      for (int i = 0; i < 16; ++i) y[et][i] *= rn * p.ret_norm_g[l * 256 + hd * 64 + 32 * et + crow(i, h)];
  } else {
#pragma unroll
    for (int et = 0; et < 2; ++et)
#pragma unroll
      for (int i = 0; i < 16; ++i) y[et][i] = o1[et][i];
  }
#pragma unroll
  for (int et = 0; et < 2; ++et)
#pragma unroll
    for (int g = 0; g < 4; ++g) {
      const int e0 = hd * 64 + 32 * et + 8 * g + 4 * h;
      const u32x2 gw = *(const u32x2*)(proj + tq * NP + GCOL + e0);
      u32x2 o; o.x = pk2(y[et][4 * g] * silu(bflo(gw.x)), y[et][4 * g + 1] * silu(bfhi(gw.x))); o.y = pk2(y[et][4 * g + 2] * silu(bflo(gw.y)), y[et][4 * g + 3] * silu(bfhi(gw.y)));
      *(u32x2*)(ybuf + tq * DM + YCOL + e0) = o;
    }
}
constexpr int KT_RS = 144;
DI bf16x8 vfrag144(LAS unsigned char* vt, int key0, int ecol, int lane) {
  const int q4 = (lane & 15) >> 2, p4 = lane & 3, blk = (lane >> 4) & 1;
  LAS unsigned char* a = vt + (key0 + q4) * KT_RS + (ecol + 16 * blk + 4 * p4) * 2;
  const s16x4 lo = __builtin_amdgcn_ds_read_tr16_b64_v4i16((LAS s16x4*)a);
  const s16x4 hi = __builtin_amdgcn_ds_read_tr16_b64_v4i16((LAS s16x4*)(a + 8 * KT_RS));
  return __builtin_shufflevector(lo, hi, 0, 1, 2, 3, 4, 5, 6, 7);
}

constexpr int W_RS = 144, W_TILE = 64 * W_RS, W_KOFF = 0, W_VOFF = 2 * W_TILE;

template <int MODE>
DI void dense256_unit(const Params& p, int l, int b, int nq, int hd, LAS unsigned char* lds) {
  constexpr int QCOL = MODE == 0 ? C_QC : C_QB, KCOL = MODE == 0 ? C_KC : C_KB, VCOL = MODE == 0 ? C_VC : C_VB, GCOL = MODE == 0 ? C_GC : C_GB, YCOL = MODE == 0 ? 512 : 256;
  int tid_ = threadIdx.x; asm volatile("" : "+v"(tid_)); const int tid = tid_, lane = tid & 63, w = tid >> 6, r = lane & 31, h = lane >> 5, qh = w & 1;
  const int cw = 4 * nq + (w >> 1);
  const u16* proj = (const u16*)(p.ws + WS_PROJ); u16* ybuf = (u16*)(p.ws + WS_XB);
  const size_t tq = (size_t)b * S + cw * 64 + qh * 32 + r;
  const int iq = qh * 32 + r;
  bf16x8 qf[4];
#pragma unroll
  for (int s = 0; s < 4; ++s) qf[s] = *(const bf16x8*)(proj + tq * NP + QCOL + hd * 64 + 16 * s + 8 * h);
  const int ntiles = 4 * nq + 4;
  const int lrow = tid >> 3, lc16 = tid & 7;
  const u16* kbase = proj + (size_t)b * S * NP + KCOL + hd * 64 + lc16 * 8; const u16* vbase = proj + (size_t)b * S * NP + VCOL + hd * 64 + lc16 * 8;
  u32x4 kr, vr;
  kr = *(const u32x4*)(kbase + (size_t)lrow * NP); vr = *(const u32x4*)(vbase + (size_t)lrow * NP);
  *(LAS u32x4*)(lds + W_KOFF + lrow * W_RS + lc16 * 16) = kr; *(LAS u32x4*)(lds + W_VOFF + lrow * W_RS + lc16 * 16) = vr;
  __syncthreads();
  f32x16 o1[2] = {zero16(), zero16()}, o2[2] = {zero16(), zero16()};
  float l1 = 0.f, l2 = 0.f;
  const float lg2g = log2f(1.0f - exp2f(-5.0f - (float)hd));
  const float cd = exp2f(lg2g * 64.0f);
  (void)l2; (void)cd; (void)lg2g; (void)iq;
#pragma unroll 1
  for (int m = 0; m < ntiles; ++m) {
    const int buf = m & 1; const bool has_next = m + 1 < ntiles;
    if (has_next) { kr = *(const u32x4*)(kbase + (size_t)((m + 1) * 64 + lrow) * NP); vr = *(const u32x4*)(vbase + (size_t)((m + 1) * 64 + lrow) * NP); }
    if (m <= cw) {
      LAS unsigned char* kt = lds + W_KOFF + buf * W_TILE; LAS unsigned char* vt = lds + W_VOFF + buf * W_TILE;
      const bool diag = (m == cw);
      if (MODE == 1) { if (m >= 1 && !diag) { o1[0] *= cd; o1[1] *= cd; } }
#pragma unroll
      for (int mt = 0; mt < 2; ++mt) {
        LAS unsigned char* krow = kt + (32 * mt + r) * W_RS + (8 * h) * 2;
        const bf16x8 a0 = *(const LAS bf16x8*)(krow), a1 = *(const LAS bf16x8*)(krow + 32), a2 = *(const LAS bf16x8*)(krow + 64), a3 = *(const LAS bf16x8*)(krow + 96);
        if (MODE == 0) {
          f32x16 s1 = zero16(), s2 = zero16();
          s1 = MFMA32(a0, qf[0], s1); s1 = MFMA32(a1, qf[1], s1); s2 = MFMA32(a2, qf[2], s2); s2 = MFMA32(a3, qf[3], s2);
#pragma unroll
          for (int i = 0; i < 16; ++i) { s1[i] = fexp2(s1[i]); l1 += s1[i]; s2[i] = fexp2(s2[i]); l2 += s2[i]; }
#pragma unroll
          for (int s = 0; s < 2; ++s) {
            const bf16x8 p1 = pack8(s1, s), p2 = pack8(s2, s);
#pragma unroll
            for (int et = 0; et < 2; ++et) { const bf16x8 vf = vfrag144(vt, 32 * mt + 16 * s + 4 * h, 32 * et, lane); o1[et] = MFMA32(vf, p1, o1[et]); o2[et] = MFMA32(vf, p2, o2[et]); }
          }
        } else {
          f32x16 sc = zero16();
          sc = MFMA32(a0, qf[0], sc); sc = MFMA32(a1, qf[1], sc); sc = MFMA32(a2, qf[2], sc); sc = MFMA32(a3, qf[3], sc);
          if (diag) {
#pragma unroll
            for (int i = 0; i < 16; ++i) { const int jk = 32 * mt + crow(i, h); const float e = (jk <= iq) ? -64.0f : (float)(2 * (jk - iq) - 64); sc[i] *= fexp2(lg2g * e); }
          }
#pragma unroll
          for (int s = 0; s < 2; ++s) {
            const bf16x8 p1 = pack8(sc, s);
#pragma unroll
            for (int et = 0; et < 2; ++et) { const bf16x8 vf = vfrag144(vt, 32 * mt + 16 * s + 4 * h, 32 * et, lane); o1[et] = MFMA32(vf, p1, o1[et]); }
          }
        }
      }
    }
    if (has_next) { *(LAS u32x4*)(lds + W_KOFF + (buf ^ 1) * W_TILE + lrow * W_RS + lc16 * 16) = kr; *(LAS u32x4*)(lds + W_VOFF + (buf ^ 1) * W_TILE + lrow * W_RS + lc16 * 16) = vr; }
    __syncthreads();
  }
  float y[2][16];
  if (MODE == 0) {
    l1 += __shfl_xor(l1, 32); l2 += __shfl_xor(l2, 32);
    float s1 = 0.f, s2 = 0.f;
    for (int i = lane; i < 32; i += 64) { s1 += p.lam_q1[l * 32 + i] * p.lam_k1[l * 32 + i]; s2 += p.lam_q2[l * 32 + i] * p.lam_k2[l * 32 + i]; }
    s1 = sum64(s1); s2 = sum64(s2);
    const float li = lam_init_of(l), lam = expf(s1) - expf(s2) + li;
    const float i1 = 1.0f / l1, i2 = lam / l2; float ss = 0.f;
#pragma unroll
    for (int et = 0; et < 2; ++et)
#pragma unroll
      for (int i = 0; i < 16; ++i) { y[et][i] = o1[et][i] * i1 - o2[et][i] * i2; ss += y[et][i] * y[et][i]; }
    ss += __shfl_xor(ss, 32);
    const float rn = rsqrtf(ss * (1.0f / 64.0f) + EPS) * (1.0f - li);
#pragma unroll
    for (int et = 0; et < 2; ++et)
#pragma unroll
      for (int i = 0; i < 16; ++i) y[et][i] *= rn * p.subln_g[l * 64 + 32 * et + crow(i, h)];
  } else {
    float sm = 0.f;
#pragma unroll
    for (int et = 0; et < 2; ++et)
#pragma unroll
      for (int i = 0; i < 16; ++i) sm += o1[et][i];
    sm += __shfl_xor(sm, 32); const float mu = sm * (1.0f / 64.0f); float sv = 0.f;
#pragma unroll
    for (int et = 0; et < 2; ++et)
#pragma unroll
      for (int i = 0; i < 16; ++i) { y[et][i] = o1[et][i] - mu; sv += y[et][i] * y[et][i]; }
    sv += __shfl_xor(sv, 32); const float rn = rsqrtf(sv * (1.0f / 64.0f) + EPS);
#pragma unroll
    for (int et = 0; et < 2; ++et)
#pragma unroll
      for (int i = 0; i < 16; ++i) y[et][i] *= rn * p.ret_norm_g[l * 256 + hd * 64 + 32 * et + crow(i, h)];
  }
#pragma unroll
  for (int et = 0; et < 2; ++et)
#pragma unroll
    for (int g = 0; g < 4; ++g) {
      const int e0 = hd * 64 + 32 * et + 8 * g + 4 * h;
      const u32x2 gw = *(const u32x2*)(proj + tq * NP + GCOL + e0);
      u32x2 o; o.x = pk2(y[et][4 * g] * silu(bflo(gw.x)), y[et][4 * g + 1] * silu(bfhi(gw.x))); o.y = pk2(y[et][4 * g + 2] * silu(bflo(gw.y)), y[et][4 * g + 3] * silu(bfhi(gw.y)));
      *(u32x2*)(ybuf + tq * DM + YCOL + e0) = o;
    }
}
constexpr int R_KT = 0, R_VT = 2 * W_TILE, R_ST = 4 * W_TILE, R_STAT = 6 * W_TILE;

DI void ret_scan_unit(const Params& p, int l, int b, int hd, LAS unsigned char* lds) {
  int tid_ = threadIdx.x; asm volatile("" : "+v"(tid_)); const int tid = tid_, lane = tid & 63, w = tid >> 6, r = lane & 31, h = lane >> 5;
  const u16* proj = (const u16*)(p.ws + WS_PROJ); u16* ybuf = (u16*)(p.ws + WS_XB);
  const int lrow = tid >> 3, lc16 = tid & 7;
  const u16* kbase = proj + (size_t)b * S * NP + C_KB + hd * 64 + lc16 * 8; const u16* vbase = proj + (size_t)b * S * NP + C_VB + hd * 64 + lc16 * 8;
  const float lg2g = log2f(1.0f - exp2f(-5.0f - (float)hd)), cd = exp2f(lg2g * 64.0f);
  const bool yw = w < 4;
  const int et = w & 1, tt = (w >> 1) & 1, dt = (w >> 1) & 1;
  const int iq = tt * 32 + r;
  for (int i = tid; i < 2 * W_TILE / 16; i += 512) { const u32x4 z = {0u, 0u, 0u, 0u}; *(LAS u32x4*)(lds + R_ST + i * 16) = z; }
  u32x4 kr = *(const u32x4*)(kbase + (size_t)lrow * NP), vr = *(const u32x4*)(vbase + (size_t)lrow * NP);
  *(LAS u32x4*)(lds + R_KT + lrow * W_RS + lc16 * 16) = kr; *(LAS u32x4*)(lds + R_VT + lrow * W_RS + lc16 * 16) = vr;
  f32x16 st = zero16();
  bf16x8 qf[4]; u32x2 gw[4];
  if (yw) {
    const size_t tq = (size_t)b * S + tt * 32 + r;
#pragma unroll
    for (int s = 0; s < 4; ++s) qf[s] = *(const bf16x8*)(proj + tq * NP + C_QB + hd * 64 + 16 * s + 8 * h);
#pragma unroll
    for (int g = 0; g < 4; ++g) gw[g] = *(const u32x2*)(proj + tq * NP + C_GB + hd * 64 + 32 * et + 8 * g + 4 * h);
  }
  float gn[16];
#pragma unroll
  for (int i = 0; i < 16; ++i) gn[i] = p.ret_norm_g[l * 256 + hd * 64 + 32 * et + crow(i, h)];
  __syncthreads();
#pragma unroll 1
  for (int n = 0; n < 128; ++n) {
    const int buf = n & 1; const bool has_next = n + 1 < 128;
    if (has_next) { kr = *(const u32x4*)(kbase + (size_t)((n + 1) * 64 + lrow) * NP); vr = *(const u32x4*)(vbase + (size_t)((n + 1) * 64 + lrow) * NP); }
    LAS unsigned char* kt = lds + R_KT + buf * W_TILE; LAS unsigned char* vt = lds + R_VT + buf * W_TILE;
    f32x16 o = zero16();
    bf16x8 qn[4]; u32x2 gwn[4];
    if (yw) {
      const size_t tqn = (size_t)b * S + (has_next ? n + 1 : n) * 64 + tt * 32 + r;
#pragma unroll
      for (int s = 0; s < 4; ++s) qn[s] = *(const bf16x8*)(proj + tqn * NP + C_QB + hd * 64 + 16 * s + 8 * h);
#pragma unroll
      for (int g = 0; g < 4; ++g) gwn[g] = *(const u32x2*)(proj + tqn * NP + C_GB + hd * 64 + 32 * et + 8 * g + 4 * h);
#pragma unroll
      for (int mt = 0; mt < 2; ++mt) {
        LAS unsigned char* krow = kt + (32 * mt + r) * W_RS + (8 * h) * 2;
        f32x16 sc = zero16();
#pragma unroll
        for (int s = 0; s < 4; ++s) sc = MFMA32(*(const LAS bf16x8*)(krow + 32 * s), qf[s], sc);
#pragma unroll
        for (int i = 0; i < 16; ++i) { const int jk = 32 * mt + crow(i, h); const float e = (jk <= iq) ? -64.0f : (float)(2 * (jk - iq) - 64); sc[i] *= fexp2(lg2g * e); }
#pragma unroll
        for (int s = 0; s < 2; ++s) { const bf16x8 pf = pack8(sc, s); const bf16x8 vf = vfrag144(vt, 32 * mt + 16 * s + 4 * h, 32 * et, lane); o = MFMA32(vf, pf, o); }
      }
      LAS unsigned char* srow = lds + R_ST + buf * W_TILE + (32 * et + r) * W_RS + (8 * h) * 2;
#pragma unroll
      for (int s = 0; s < 4; ++s) o = MFMA32(*(const LAS bf16x8*)(srow + 32 * s), qf[s], o);
      float sy = 0.f, sy2 = 0.f;
#pragma unroll
      for (int i = 0; i < 16; ++i) { sy += o[i]; sy2 += o[i] * o[i]; }
      sy = xsum32(sy); sy2 = xsum32(sy2);
      if (h == 0) { f32x2 v2 = {sy, sy2}; *(LAS f32x2*)(lds + R_STAT + ((buf * 4 + w) * 32 + r) * 8) = v2; }
    } else {
      st *= cd;
#pragma unroll
      for (int s = 0; s < 4; ++s) { const bf16x8 af = vfrag144(kt, 16 * s + 4 * h, 32 * dt, lane), bfr = vfrag144(vt, 16 * s + 4 * h, 32 * et, lane); st = MFMA32(af, bfr, st); }
      LAS unsigned char* sw = lds + R_ST + (buf ^ 1) * W_TILE + (32 * et + r) * W_RS + (32 * dt + 4 * h) * 2;
#pragma unroll
      for (int g = 0; g < 4; ++g) { u32x2 ow; ow.x = pk2(st[4 * g], st[4 * g + 1]); ow.y = pk2(st[4 * g + 2], st[4 * g + 3]); *(LAS u32x2*)(sw + 16 * g) = ow; }
    }
    if (has_next) { *(LAS u32x4*)(lds + R_KT + (buf ^ 1) * W_TILE + lrow * W_RS + lc16 * 16) = kr; *(LAS u32x4*)(lds + R_VT + (buf ^ 1) * W_TILE + lrow * W_RS + lc16 * 16) = vr; }
    __syncthreads();
    if (yw) {
      const f32x2 ps = *(const LAS f32x2*)(lds + R_STAT + ((buf * 4 + (w ^ 1)) * 32 + r) * 8);
      float sy = 0.f, sy2 = 0.f;
#pragma unroll
      for (int i = 0; i < 16; ++i) { sy += o[i]; sy2 += o[i] * o[i]; }
      sy = xsum32(sy) + ps[0]; sy2 = xsum32(sy2) + ps[1];
      const float mu = sy * (1.0f / 64.0f), var = fmaxf(sy2 * (1.0f / 64.0f) - mu * mu, 0.f), rn = rsqrtf(var + EPS);
      const size_t tq = (size_t)b * S + n * 64 + tt * 32 + r;
#pragma unroll
      for (int g = 0; g < 4; ++g) {
        const int e0 = hd * 64 + 32 * et + 8 * g + 4 * h;
        u32x2 ow; ow.x = pk2((o[4 * g] - mu) * rn * gn[4 * g] * silu(bflo(gw[g].x)), (o[4 * g + 1] - mu) * rn * gn[4 * g + 1] * silu(bfhi(gw[g].x)));
        ow.y = pk2((o[4 * g + 2] - mu) * rn * gn[4 * g + 2] * silu(bflo(gw[g].y)), (o[4 * g + 3] - mu) * rn * gn[4 * g + 3] * silu(bfhi(gw[g].y)));
        *(u32x2*)(ybuf + tq * DM + 256 + e0) = ow;
      }
#pragma unroll
      for (int s = 0; s < 4; ++s) qf[s] = qn[s];
#pragma unroll
      for (int g = 0; g < 4; ++g) gw[g] = gwn[g];
    }
  }
  __syncthreads();
}
constexpr int A_CAND = 0, A_KT = 98304, A_CAP = 768;
constexpr int KT_KEYS = 128, KT_BYTES = KT_KEYS * KT_RS, VT_BYTES = 32 * KT_RS;

DI void lds_wave_sync() { asm volatile("s_waitcnt lgkmcnt(0)" ::: "memory"); __builtin_amdgcn_wave_barrier(); asm volatile("" ::: "memory"); }
DI void wave_sync() { __builtin_amdgcn_fence(__ATOMIC_RELEASE, "wavefront"); __builtin_amdgcn_wave_barrier(); __builtin_amdgcn_fence(__ATOMIC_ACQUIRE, "wavefront"); }

template <int LIM> DI int topk_cut(LAS unsigned* cand, int cnt, unsigned& tauq, int lane) {
  if (cnt <= 256) return cnt;
  wave_sync();
  constexpr int NE = A_CAP / 64;
  unsigned e[NE];
#pragma unroll
  for (int i = 0; i < NE; ++i) { const int j = lane + 64 * i; e[i] = j < cnt ? cand[j] : 0u; }
  const unsigned ref = __builtin_amdgcn_readfirstlane(e[0]);
  unsigned df = 0u;
#pragma unroll
  for (int i = 0; i < NE; ++i) df |= (lane + 64 * i < cnt) ? (e[i] ^ ref) : 0u;
  df |= __shfl_xor(df, 1); df |= __shfl_xor(df, 2); df |= __shfl_xor(df, 4); df |= __shfl_xor(df, 8); df |= __shfl_xor(df, 16); df |= __shfl_xor(df, 32);
  df = __builtin_amdgcn_readfirstlane(df);
  const int hb = 31 - __builtin_clz(df | 1u);
  unsigned V = hb >= 31 ? 0u : (ref & ~((2u << hb) - 1u));
#pragma unroll 1
  for (int bit = hb; bit >= 0; --bit) {
    const unsigned cv = V | (1u << bit); int c = 0;
#pragma unroll
    for (int i = 0; i < NE; ++i) c += __popcll(__ballot(e[i] >= cv));
    if (c >= 256) V = cv;
    if (c >= 256 && c <= LIM) break;
  }
  int nc = 0;
#pragma unroll
  for (int i = 0; i < NE; ++i) {
    const bool pr = e[i] >= V; const unsigned long long bal = __ballot(pr);
    const int pos = nc + __popcll(bal & ((1ull << lane) - 1ull));
    if (pr) cand[pos] = e[i];
    nc += __popcll(bal);
  }
  wave_sync();
  tauq = V;
  return nc;
}

DI void dsa_unit(const Params& p, int l, int b, int g32, LAS unsigned char* lds) {
  int tid_ = threadIdx.x; asm volatile("" : "+v"(tid_)); const int tid = tid_, lane = tid & 63, w = tid >> 6, r = lane & 31, h = lane >> 5;
  const u16* proj = (const u16*)(p.ws + WS_PROJ); u16* ybuf = (u16*)(p.ws + WS_XB);
  const int n = g32 >> 1, end = (n + 1) * 64; const size_t tq0 = (size_t)b * S + g32 * 32 + 4 * w;
  LAS unsigned* cand = (LAS unsigned*)(lds + A_CAND) + (4 * w) * A_CAP;
  bf16x8 af[4];
  { const int ql = 2 * ((r >> 2) & 1) + (r >> 4), hdx = (((r >> 3) & 1) << 2) | (r & 3);
#pragma unroll
    for (int s = 0; s < 4; ++s) af[s] = *(const bf16x8*)(proj + (tq0 + ql) * NP + C_QI + hdx * 64 + 16 * s + 8 * h); }
  float w0[8], w1[8];
  { const u32x4 wa = *(const u32x4*)(proj + (tq0 + 2 * h) * NP + C_WI), wb = *(const u32x4*)(proj + (tq0 + 2 * h + 1) * NP + C_WI);
#pragma unroll
    for (int i = 0; i < 4; ++i) { w0[2 * i] = 0.5f * bflo(wa[i]); w0[2 * i + 1] = 0.5f * bfhi(wa[i]); w1[2 * i] = 0.5f * bflo(wb[i]); w1[2 * i + 1] = 0.5f * bfhi(wb[i]); } }
  int cnt0 = 0, cnt1 = 0, cnt2 = 0, cnt3 = 0; unsigned tau0 = 0u, tau1 = 0u, tau2 = 0u, tau3 = 0u;
  const u16* kglob = (const u16*)(p.ws + WS_KIC) + (size_t)b * S * 64;
  u32x4 krA[2], krB[2];
  const int kc0 = tid >> 3, kp0 = (tid & 7);
#define DSA_LOADT(R, tile) do { _Pragma("unroll") for (int i_ = 0; i_ < 2; ++i_) R[i_] = *(const u32x4*)(kglob + (size_t)((tile) * KT_KEYS + kc0 + 64 * i_) * 64 + kp0 * 8); } while (0)
#define DSA_STORET(R, bufi) do { _Pragma("unroll") for (int i_ = 0; i_ < 2; ++i_) *(LAS u32x4*)(lds + A_KT + (bufi) * KT_BYTES + (kc0 + 64 * i_) * KT_RS + kp0 * 16) = R[i_]; } while (0)
#define DSA_INSERT(v, KEYV, INR, tauv, QA, QB, cntA, cntB) do { \
    const unsigned f = __float_as_uint(v); const unsigned mono = f ^ ((unsigned)((int)f >> 31) | 0x80000000u); \
    const unsigned pk = (mono & 0xFFFFE000u) | (KEYV); \
    const bool pr = (pk > (tauv)) && (INR); \
    const unsigned long long bal = __builtin_amdgcn_ballot_w64(pr); \
    if (bal != 0ull) { \
      const unsigned m0 = (unsigned)bal, m1 = (unsigned)(bal >> 32); \
      const int pm0 = __popc(m0); \
      const int sA = (QA) * A_CAP + cntA, sB = (QB) * A_CAP + cntB - pm0;     \
      const int pos = (int)__builtin_amdgcn_mbcnt_hi(m1, __builtin_amdgcn_mbcnt_lo(m0, 0u)) + sA + (hneg & (sB - sA)); \
      if (pr) cand[pos] = pk; \
      cntA += pm0; cntB += __popc(m1); \
    } } while (0)
#define DSA_BODY(K0, BUFI) do { \
    LAS unsigned char* kt = lds + A_KT + (BUFI) * KT_BYTES + r * KT_RS + h * 16; \
    const int hneg = -h; const unsigned tauvA = h ? tau2 : tau0, tauvB = h ? tau3 : tau1;     \
    f32x16 acc[4];                      \
    _Pragma("unroll") for (int t = 0; t < 4; ++t) acc[t] = zero16(); \
    _Pragma("unroll") for (int s = 0; s < 4; ++s) \
      _Pragma("unroll") for (int t = 0; t < 4; ++t) { const bf16x8 kf = *(const LAS bf16x8*)(kt + (32 * t) * KT_RS + 32 * s); acc[t] = MFMA32(af[s], kf, acc[t]); } \
    float s0[4], s1[4]; \
    _Pragma("unroll") for (int t = 0; t < 4; ++t) { s0[t] = 0.f; s1[t] = 0.f; \
      _Pragma("unroll") for (int i = 0; i < 8; ++i) { s0[t] = fmaf(w0[i], acc[t][i], s0[t]); s0[t] = fmaf(w0[i], __builtin_fabsf(acc[t][i]), s0[t]); s1[t] = fmaf(w1[i], acc[t][8 + i], s1[t]); s1[t] = fmaf(w1[i], __builtin_fabsf(acc[t][8 + i]), s1[t]); } } \
    _Pragma("unroll") for (int t = 0; t < 4; ++t) { \
      const unsigned keyv = (unsigned)((K0) + 32 * t + r); const bool inr = (K0) + 32 * t < end; \
      DSA_INSERT(s0[t], keyv, inr, tauvA, 0, 2, cnt0, cnt2); \
      DSA_INSERT(s1[t], keyv, inr, tauvB, 1, 3, cnt1, cnt3); \
    } \
    if (cnt0 > A_CAP - KT_KEYS) cnt0 = topk_cut<272>(cand, cnt0, tau0, lane); \
    if (cnt1 > A_CAP - KT_KEYS) cnt1 = topk_cut<272>(cand + A_CAP, cnt1, tau1, lane); \
    if (cnt2 > A_CAP - KT_KEYS) cnt2 = topk_cut<272>(cand + 2 * A_CAP, cnt2, tau2, lane); \
    if (cnt3 > A_CAP - KT_KEYS) cnt3 = topk_cut<272>(cand + 3 * A_CAP, cnt3, tau3, lane); \
  } while (0)
  const int nstep = (end + KT_KEYS - 1) / KT_KEYS;
#if defined(PROBE_SEL2)
  for (int rep_ = 0; rep_ < 2; ++rep_) { cnt0 = cnt1 = cnt2 = cnt3 = 0; tau0 = tau1 = tau2 = tau3 = 0u; __syncthreads();
#endif
  LAS int* cflag = (LAS int*)(lds + A_KT + 2 * KT_BYTES);
  if (tid < 3) cflag[tid] = 0;
  DSA_LOADT(krA, 0);
  if (nstep > 1) DSA_LOADT(krB, 1);
  DSA_STORET(krA, 0);
  __syncthreads();
#define DSA_SYNC_CUT(STC) do { \
    const int fi_ = (STC) % 3; \
    if ((cnt0 > CUT_SOFT || cnt1 > CUT_SOFT || cnt2 > CUT_SOFT || cnt3 > CUT_SOFT) && lane == 0) cflag[fi_] = 1; \
    if (tid == 0) cflag[((STC) + 1) % 3] = 0; \
    __syncthreads(); \
    if (cflag[fi_] != 0) { \
      if (cnt0 > CUT_MIN) cnt0 = topk_cut<272>(cand, cnt0, tau0, lane); \
      if (cnt1 > CUT_MIN) cnt1 = topk_cut<272>(cand + A_CAP, cnt1, tau1, lane); \
      if (cnt2 > CUT_MIN) cnt2 = topk_cut<272>(cand + 2 * A_CAP, cnt2, tau2, lane); \
      if (cnt3 > CUT_MIN) cnt3 = topk_cut<272>(cand + 3 * A_CAP, cnt3, tau3, lane); \
    } } while (0)
  constexpr int CUT_SOFT = 560, CUT_MIN = 400;
#pragma unroll 1
  for (int st = 0; st < nstep; st += 2) {
    if (st + 2 < nstep) DSA_LOADT(krA, st + 2);
    DSA_BODY(st * KT_KEYS, 0);
    if (st + 1 < nstep) DSA_STORET(krB, 1);
    __syncthreads();
    if (st + 1 < nstep) {
      if (st + 3 < nstep) DSA_LOADT(krB, st + 3);
      DSA_BODY((st + 1) * KT_KEYS, 1);
      if (st + 2 < nstep) DSA_STORET(krA, 0);
      DSA_SYNC_CUT(st >> 1);
    }
  }
#undef DSA_SYNC_CUT
#if defined(PROBE_SEL2)
  }
#endif
#undef DSA_LOADT
#undef DSA_STORET
#undef DSA_BODY
#undef DSA_INSERT
  LAS unsigned char* vt = lds + A_KT + w * VT_BYTES;
  const u16* kvc = (const u16*)(p.ws + WS_KVC);
  const int ks = lane >> 3, dg = lane & 7;
#pragma unroll 1
  for (int qq = 0; qq < 4; ++qq) {
    const size_t tq = tq0 + qq;
    LAS unsigned* cq = cand + qq * A_CAP;
    unsigned tau_unused = 0u;
    const int nc = topk_cut<256>(cq, qq == 0 ? cnt0 : (qq == 1 ? cnt1 : (qq == 2 ? cnt2 : cnt3)), tau_unused, lane);
    wave_sync();
#if defined(PROBE_GAT2)
    for (int rep_ = 0; rep_ < 2; ++rep_) {
#endif
#if defined(PROBE_GAT2)
    for (int rep_ = 0; rep_ < 2; ++rep_) {
#endif
    bf16x8 qb[4];
#pragma unroll
    for (int s = 0; s < 4; ++s) { u32x4 z = {0u, 0u, 0u, 0u}; if (r < 4) z = *(const u32x4*)(proj + tq * NP + C_QA + r * 64 + 16 * s + 8 * h); qb[s] = __builtin_bit_cast(bf16x8, z); }
    f32x16 o[2] = {zero16(), zero16()}; float lsum = 0.f;
    u32x4 ka[4], va4[4];
    {
      const unsigned ik = cq[r] & 0x1FFFu; const u16* kp = kvc + ((size_t)b * S + ik) * 128 + 8 * h;
#pragma unroll
      for (int s = 0; s < 4; ++s) ka[s] = *(const u32x4*)(kp + 16 * s);
#pragma unroll
      for (int u = 0; u < 4; ++u) { const unsigned iv = cq[8 * u + ks] & 0x1FFFu; va4[u] = *(const u32x4*)(kvc + ((size_t)b * S + iv) * 128 + 64 + 8 * dg); }
    }
    const int ntile = nc >> 5;
#pragma unroll 1
    for (int mt = 0; mt < ntile; ++mt) {
      bf16x8 a[4];
#pragma unroll
      for (int s = 0; s < 4; ++s) a[s] = __builtin_bit_cast(bf16x8, ka[s]);
#pragma unroll
      for (int u = 0; u < 4; ++u) *(LAS u32x4*)(vt + (8 * u + ks) * KT_RS + dg * 16) = va4[u];
      if (mt + 1 < ntile) {
        const unsigned ik = cq[32 * (mt + 1) + r] & 0x1FFFu; const u16* kp = kvc + ((size_t)b * S + ik) * 128 + 8 * h;
#pragma unroll
        for (int s = 0; s < 4; ++s) ka[s] = *(const u32x4*)(kp + 16 * s);
#pragma unroll
        for (int u = 0; u < 4; ++u) { const unsigned iv = cq[32 * (mt + 1) + 8 * u + ks] & 0x1FFFu; va4[u] = *(const u32x4*)(kvc + ((size_t)b * S + iv) * 128 + 64 + 8 * dg); }
      }
      f32x16 sc = zero16();
#pragma unroll
      for (int s = 0; s < 4; ++s) sc = MFMA32(a[s], qb[s], sc);
#pragma unroll
      for (int i = 0; i < 16; ++i) { sc[i] = fexp2(sc[i]); lsum += sc[i]; }
      lds_wave_sync();
#pragma unroll
      for (int s = 0; s < 2; ++s) {
        const bf16x8 pf = pack8(sc, s);
#pragma unroll
        for (int et = 0; et < 2; ++et) { const bf16x8 vf = vfrag144(vt, 16 * s + 4 * h, 32 * et, lane); o[et] = MFMA32(vf, pf, o[et]); }
      }
      lds_wave_sync();
    }
    lsum = xsum32(lsum);
    if (r < 4) {
      const float inv = 1.0f / lsum;
#pragma unroll
      for (int et = 0; et < 2; ++et)
#pragma unroll
        for (int g = 0; g < 4; ++g) {
          const int e0 = r * 64 + 32 * et + 8 * g + 4 * h;
          const u32x2 gw = *(const u32x2*)(proj + tq * NP + C_GA + e0);
          u32x2 ow; ow.x = pk2(o[et][4 * g] * inv * silu(bflo(gw.x)), o[et][4 * g + 1] * inv * silu(bfhi(gw.x))); ow.y = pk2(o[et][4 * g + 2] * inv * silu(bflo(gw.y)), o[et][4 * g + 3] * inv * silu(bfhi(gw.y)));
          *(u32x2*)(ybuf + tq * DM + e0) = ow;
        }
    }
#if defined(PROBE_GAT2)
    wave_sync(); }
#endif
#if defined(PROBE_GAT2)
    wave_sync(); }
#endif
  }
  __syncthreads();
}
constexpr int MIX_UNITS_B = 516;

#if !defined(MULTI_LAUNCH)
__global__ void __launch_bounds__(512) hybrid_fwd(Params p) {
  extern __shared__ __attribute__((aligned(16))) unsigned char lds_g[];
  LAS unsigned char* lds = (LAS unsigned char*)lds_g;
  cg::grid_group grid = cg::this_grid();
  const int tid = threadIdx.x;
  unsigned* ctl = (unsigned*)(p.ws + WS_CTL);
  if (blockIdx.x == 0 && tid < 64) ctl[tid] = 0u;
  prep_weights(p, lds);
  prep_x(p, p.x);
  grid.sync();
#pragma unroll 1
  for (int l = 0; l < 2; ++l) {
    {
      pg8::StaticOrder so; so.init(MTOK, NP, (int)gridDim.x, (int)blockIdx.x);
      if (l == 0) {
        pg8::Gemm g{(const u16*)(p.ws + WS_XB), (const u16*)(p.ws + WS_WIN), MTOK, NP, DM};
        pg8::EpiProj E{(u16*)(p.ws + WS_PROJ), (const float*)(p.ws + WS_RROW)};
        pg8::gemm_phase<pg8::EpiProj, pg8::StaticOrder, true, true>(lds, g, so, E);
      } else {
        pg8::Gemm g{(const u16*)(p.ws + WS_XB2), (const u16*)(p.ws + WS_WIN) + (size_t)l * NP * DM, MTOK, NP, DM};
        pg8::EpiProj2 E{(u16*)(p.ws + WS_PROJ), (const float*)(p.ws + WS_RSS)};
        pg8::gemm_phase<pg8::EpiProj2, pg8::StaticOrder, true, true>(lds, g, so, E);
      }
    }
    grid.sync();
#pragma unroll 1
    for (int u = blockIdx.x; u < NB * 128; u += gridDim.x) post_unit(p, l, u, lds);
    grid.sync();
    {
      LAS int* slot = (LAS int*)(lds + LDS_BYTES - 16);
      const int q0 = (int)((unsigned)__builtin_amdgcn_s_getreg((3 << 11) | 20) & 7u);
#pragma unroll 1
      for (int qi = 0; qi < 8; ++qi) {
        const int bq = (q0 + qi) & 7;
#pragma unroll 1
        for (;;) {
          if (tid == 0) *slot = (int)atomicAdd(ctl + l * 8 + bq, 1u);
          __syncthreads();
          const int idx = *slot;
          __syncthreads();
          if (idx >= MIX_UNITS_B) break;
          if (idx < 4) ret_scan_unit(p, l, bq, idx, lds);
          else if (idx < 132) dense256_unit<0>(p, l, bq, 31 - ((idx - 4) & 31), (idx - 4) >> 5, lds);
          else if (idx < 388) dsa_unit(p, l, bq, 255 - (idx - 132), lds);
          else dense_unit<2>(p, l, bq, 127 - (idx - 388), lds);
        }
      }
    }
    grid.sync();
    {
      pg8::Gemm g{(const u16*)(p.ws + WS_XB), (const u16*)(p.ws + WS_WOUT) + (size_t)l * DM * DM, MTOK, DM, DM};
      pg8::StaticOrder so; so.init(MTOK, DM, (int)gridDim.x, (int)blockIdx.x);
      if (l == 0) { pg8::EpiResNext E{p.x, p.out, (u16*)(p.ws + WS_XB2), (float*)(p.ws + WS_RSS)}; pg8::gemm_phase<pg8::EpiResNext, pg8::StaticOrder, true, true>(lds, g, so, E); }
      else { pg8::EpiRes E{(const float*)p.out, p.out}; pg8::gemm_phase<pg8::EpiRes, pg8::StaticOrder, true, true>(lds, g, so, E); }
    }
    if (l == 0) grid.sync();
  }
}


#endif
#if defined(MULTI_LAUNCH)
template <int PH> __global__ void __launch_bounds__(512) phase_k(Params p, int l, int rep) {
  extern __shared__ __attribute__((aligned(16))) unsigned char lds_g[];
  LAS unsigned char* lds = (LAS unsigned char*)lds_g;
  const int tid = threadIdx.x; unsigned* ctl = (unsigned*)(p.ws + WS_CTL);
  if (PH == 0) { if (blockIdx.x == 0 && tid < 64) ctl[tid] = 0u; prep_weights(p, lds); prep_x(p, p.x); }
  if (PH == 1) { pg8::Gemm g{(const u16*)(p.ws + WS_XB), (const u16*)(p.ws + WS_WIN) + (size_t)l * NP * DM, MTOK, NP, DM};
      pg8::StaticOrder so; so.init(MTOK, NP, (int)gridDim.x, (int)blockIdx.x); pg8::EpiProj E{(u16*)(p.ws + WS_PROJ), (const float*)(p.ws + WS_RROW)};
      pg8::gemm_phase<pg8::EpiProj, pg8::StaticOrder, true, true>(lds, g, so, E); }
  if (PH == 2) { for (int u = blockIdx.x; u < NB * 128; u += gridDim.x) post_unit(p, l, u, lds); }
  if (PH >= 3 && PH <= 6) {
      LAS int* slot = (LAS int*)(lds + LDS_BYTES - 16);
      for (;;) {
        if (tid == 0) *slot = (int)atomicAdd(ctl + (l * 2 + rep) * 8 + (PH - 3), 1u);
        __syncthreads(); const int idx = *slot; __syncthreads();
        if (PH == 3) { if (idx >= 1024) break; dense256_unit<0>(p, l, idx & 7, 31 - (idx >> 5), (idx >> 3) & 3, lds); }
        if (PH == 4) { if (idx >= 32) break; ret_scan_unit(p, l, idx & 7, idx >> 3, lds); }
        if (PH == 5) { if (idx >= 2048) break; dsa_unit(p, l, idx & 7, 255 - (idx >> 3), lds); }
        if (PH == 6) { if (idx >= 1024) break; dense_unit<2>(p, l, idx & 7, 127 - (idx >> 3), lds); }
      } }
  if (PH == 7) { pg8::Gemm g{(const u16*)(p.ws + WS_XB), (const u16*)(p.ws + WS_WOUT) + (size_t)l * DM * DM, MTOK, DM, DM};
      pg8::StaticOrder so; so.init(MTOK, DM, (int)gridDim.x, (int)blockIdx.x); pg8::EpiRes E{l == 0 ? p.x : (const float*)p.out, p.out};
      pg8::gemm_phase<pg8::EpiRes, pg8::StaticOrder, true, true>(lds, g, so, E); }
  if (PH == 8) prep_x(p, p.out);
}
template <int PH> static void launch_phase(const Params& p, int l, hipStream_t stream, int rep = 0) {
  static bool attr = false; if (!attr) { (void)hipFuncSetAttribute((const void*)phase_k<PH>, hipFuncAttributeMaxDynamicSharedMemorySize, LDS_BYTES); attr = true; }
  hipLaunchKernelGGL(phase_k<PH>, dim3(256), dim3(512), LDS_BYTES, stream, p, l, rep);
}

#endif

extern "C" void kernel_launch(void* const* d_in, const int* in_sizes, int n_in, void* d_out, int out_size, void* d_ws, size_t ws_size, hipStream_t stream) {
  static int grid_blocks = 0;
  if (grid_blocks == 0) {
    if (n_in != 17 || in_sizes[0] != MTOK * DM || out_size != MTOK * DM || ws_size < WS_END) { fprintf(stderr, "kernel_launch: unexpected shapes (n_in %d, ws %zu, need %zu)\n", n_in, ws_size, (size_t)WS_END); grid_blocks = -1; return; }
    int dev = 0, cus = 0, per_cu = 0;
    (void)hipGetDevice(&dev); (void)hipDeviceGetAttribute(&cus, hipDeviceAttributeMultiprocessorCount, dev);
#if !defined(MULTI_LAUNCH)
    if (hipFuncSetAttribute((const void*)hybrid_fwd, hipFuncAttributeMaxDynamicSharedMemorySize, LDS_BYTES) != hipSuccess) { fprintf(stderr, "kernel_launch: hipFuncSetAttribute failed\n"); grid_blocks = -1; return; }
    if (hipOccupancyMaxActiveBlocksPerMultiprocessor(&per_cu, (const void*)hybrid_fwd, 512, LDS_BYTES) != hipSuccess || per_cu < 1) { fprintf(stderr, "kernel_launch: occupancy query says %d\n", per_cu); per_cu = 1; }
#else
    per_cu = 1;
#endif
    (void)hipGetLastError();
    grid_blocks = cus * per_cu;
  }
  if (grid_blocks < 0) return;
  Params p{};
  p.x = (const float*)d_in[0]; p.pos = (const int*)d_in[1]; p.norm_g = (const float*)d_in[2]; p.w_in = (const float*)d_in[3]; p.kv_norm_g = (const float*)d_in[4];
  p.w_kv_up = (const float*)d_in[5]; p.q_norm_a = (const float*)d_in[6]; p.k_norm_a = (const float*)d_in[7]; p.ret_norm_g = (const float*)d_in[8];
  p.q_norm_c = (const float*)d_in[9]; p.k_norm_c = (const float*)d_in[10]; p.lam_q1 = (const float*)d_in[11]; p.lam_k1 = (const float*)d_in[12];
  p.lam_q2 = (const float*)d_in[13]; p.lam_k2 = (const float*)d_in[14]; p.subln_g = (const float*)d_in[15]; p.w_out = (const float*)d_in[16];
  p.out = (float*)d_out; p.ws = (unsigned char*)d_ws;
#if defined(MULTI_LAUNCH)
  launch_phase<0>(p, 0, stream);
  for (int l = 0; l < 2; ++l) {
#ifndef DUP_PH
#define DUP_PH -1
#endif
    launch_phase<1>(p, l, stream); if (DUP_PH == 1) launch_phase<1>(p, l, stream, 1);
    launch_phase<2>(p, l, stream); if (DUP_PH == 2) { launch_phase<1>(p, l, stream, 1); launch_phase<2>(p, l, stream, 1); }
    launch_phase<3>(p, l, stream); if (DUP_PH == 3) launch_phase<3>(p, l, stream, 1);
    launch_phase<4>(p, l, stream); if (DUP_PH == 4) launch_phase<4>(p, l, stream, 1);
    launch_phase<5>(p, l, stream); if (DUP_PH == 5) launch_phase<5>(p, l, stream, 1);
    launch_phase<6>(p, l, stream); if (DUP_PH == 6) launch_phase<6>(p, l, stream, 1);
    launch_phase<7>(p, l, stream); if (DUP_PH == 7 && l == 0) launch_phase<7>(p, l, stream, 1);
    if (l == 0) { launch_phase<8>(p, l, stream); if (DUP_PH == 8) launch_phase<8>(p, l, stream, 1); }
  }
#else
  void* args[] = {&p};
  hipError_t e = hipLaunchCooperativeKernel((const void*)hybrid_fwd, dim3(grid_blocks), dim3(512), args, LDS_BYTES, stream);
  if (e != hipSuccess) fprintf(stderr, "cooperative launch failed: %s (grid %d)\n", hipGetErrorString(e), grid_blocks);
#endif
}
```

```cpp
#include <hip/hip_runtime.h>
#include <hip/hip_cooperative_groups.h>
#include <cstdio>
#include <cstdint>
namespace cg = cooperative_groups;

#define DI __device__ __forceinline__
#define LAS __attribute__((address_space(3)))
typedef unsigned short u16;
typedef short bf16x8 __attribute__((ext_vector_type(8)));
typedef short s16x4 __attribute__((ext_vector_type(4)));
typedef float f32x16 __attribute__((ext_vector_type(16)));
typedef float f32x4 __attribute__((ext_vector_type(4)));
typedef float f32x2 __attribute__((ext_vector_type(2)));
typedef unsigned u32x4 __attribute__((ext_vector_type(4)));
typedef unsigned u32x2 __attribute__((ext_vector_type(2)));
typedef __bf16 bf16x2_t __attribute__((ext_vector_type(2)));
#define MFMA32(a, b, c) __builtin_amdgcn_mfma_f32_32x32x16_bf16((a), (b), (c), 0, 0, 0)

constexpr int NB = 8, S = 8192, DM = 1024, MTOK = NB * S, NP = 4352, DIN = 4296;
constexpr float EPS = 1e-6f;
constexpr float LOG2E = 1.4426950408889634f;
constexpr int C_QA = 0, C_KA = 256, C_VA = 320, C_QI = 384, C_KI = 896, C_GA = 960;
constexpr int C_QB = 1216, C_KB = 1472, C_VB = 1728, C_GB = 1984;
constexpr int C_QC = 2240, C_KC = 2496, C_VC = 2752, C_GC = 3008;
constexpr int C_QD = 3264, C_KD = 3520, C_VD = 3776, C_GD = 4032, C_WI = 4288;
constexpr size_t WS_CTL = 0, WS_RROW = 4096, WS_WIN = 1u << 20, WS_WOUT = WS_WIN + (size_t)2 * NP * DM * 2, WS_WKV = WS_WOUT + (size_t)2 * DM * DM * 2,
                 WS_RSS = (size_t)24 << 20  ,
                 WS_XB = (size_t)32 << 20, WS_PROJ = WS_XB + (size_t)MTOK * DM * 2, WS_XB2 = WS_PROJ + (size_t)MTOK * NP * 2, WS_KVC = WS_XB2 + (size_t)MTOK * DM * 2  ,
                 WS_KIC = WS_KVC + (size_t)MTOK * 128 * 2  , WS_END = WS_KIC + (size_t)MTOK * 64 * 2;
constexpr int LDS_BYTES = 143360;

struct Params {
  const float* x; const int* pos; const float* norm_g; const float* w_in; const float* kv_norm_g; const float* w_kv_up;
  const float* q_norm_a; const float* k_norm_a; const float* ret_norm_g; const float* q_norm_c; const float* k_norm_c;
  const float* lam_q1; const float* lam_k1; const float* lam_q2; const float* lam_k2; const float* subln_g; const float* w_out;
  float* out; unsigned char* ws;
};

DI unsigned pk2(float lo, float hi) { f32x2 x = {lo, hi}; return __builtin_bit_cast(unsigned, __builtin_convertvector(x, bf16x2_t)); }
DI float bflo(unsigned w) { return __uint_as_float(w << 16); }
DI float bfhi(unsigned w) { return __uint_as_float(w & 0xffff0000u); }
DI float bf2f(u16 v) { return __uint_as_float((unsigned)v << 16); }
DI u16 f2bf(float f) { return (u16)(pk2(f, 0.f) & 0xffffu); }
DI float fexp2(float x) { return __builtin_amdgcn_exp2f(x); }
DI float frcp(float x) { return __builtin_amdgcn_rcpf(x); }
DI float silu(float x) { return x * frcp(1.0f + fexp2(-x * LOG2E)); }
DI int crow(int i, int h) { return (i & 3) + 8 * (i >> 2) + 4 * h; }
DI bf16x8 pack8(const f32x16& x, int s) {
  u32x4 p; p[0] = pk2(x[8 * s], x[8 * s + 1]); p[1] = pk2(x[8 * s + 2], x[8 * s + 3]); p[2] = pk2(x[8 * s + 4], x[8 * s + 5]); p[3] = pk2(x[8 * s + 6], x[8 * s + 7]);
  return __builtin_bit_cast(bf16x8, p);
}
DI f32x16 zero16() { f32x16 z; for (int i = 0; i < 16; ++i) z[i] = 0.f; return z; }
DI float sum16(float v) { v += __shfl_xor(v, 8); v += __shfl_xor(v, 4); v += __shfl_xor(v, 2); v += __shfl_xor(v, 1); return v; }
DI float sum32(float v) { v += __shfl_xor(v, 16); return sum16(v); }
DI float sum64(float v) { v += __shfl_xor(v, 32); return sum32(v); }
DI float lam_init_of(int l) { return l == 0 ? 0.2f : 0.35550907f; }
DI float xsum16(float x) { const unsigned u = __float_as_uint(x); const auto r = __builtin_amdgcn_permlane16_swap(u, u, false, false); return __uint_as_float(r[0]) + __uint_as_float(r[1]); }
DI float xsum32(float x) { const unsigned u = __float_as_uint(x); const auto r = __builtin_amdgcn_permlane32_swap(u, u, false, false); return __uint_as_float(r[0]) + __uint_as_float(r[1]); }

namespace pg8 {
#define PG8_LAS __attribute__((address_space(3)))
typedef unsigned short bf16_t;
typedef short bf16x8 __attribute__((ext_vector_type(8)));
typedef float f32x4 __attribute__((ext_vector_type(4)));
typedef unsigned u32x4 __attribute__((ext_vector_type(4)));
constexpr int BM = 256, BK = 64, HALF = 128, HTB = HALF * BK * 2  , STAGE_BYTES = 8 * HTB, NXCD = 8, WGM = 8;

__host__ __device__ __forceinline__ int lds_byte(int r, int c) { const int st = (r >> 4) * 2 + (c >> 5), rr = r & 15, cc = c & 31, ob = rr * 64 + cc * 2; return st * 1024 + (ob ^ (((ob >> 9) & 1) << 5)); }
__host__ __device__ __forceinline__ void stage_rc(int b, int& R, int& C) { const int st = b / 1024, sb = b % 1024, swz = sb ^ (((sb >> 9) & 1) << 5); R = (st >> 1) * 16 + swz / 64; C = (st & 1) * 32 + (swz % 64) / 2; }
__host__ __device__ __forceinline__ int perm32(int rho) { const int n = rho >> 4, i = rho & 15; return 8 * (i >> 2) + 4 * n + (i & 3); }

struct Unit { int pm, pn; };
struct Gemm { const bf16_t* A; const bf16_t* Bt; int M, N, K; };

struct StaticOrder {
    int nM, nN, nwg, G, c;
    __host__ __device__ void init(int M, int N, int G_, int c_) { nM = M / BM; nN = N / BM; nwg = nM * nN; G = G_; c = c_; }
    __host__ __device__ bool next(int i, Unit& u) const {
        const long L = (long)i * G + c; if (L >= nwg) return false;
        int wgid = (int)L; { const int q = nwg / NXCD, r = nwg % NXCD, xcd = wgid % NXCD, off = wgid / NXCD; wgid = (xcd < r ? xcd * (q + 1) : r * (q + 1) + (xcd - r) * q) + off; }
        const int nig = WGM * nN, gid = wgid / nig, fm = gid * WGM, gsz = (nM - fm) < WGM ? (nM - fm) : WGM;
        u.pm = fm + ((wgid % nig) % gsz); u.pn = (wgid % nig) / gsz; return true;
    }
    __device__ __forceinline__ void a_ready(const Unit&) const {}
    __device__ __forceinline__ void done(const Unit&) const {}
};

struct EpiProj {
    static constexpr bool PERM = true, AFTER_DRAIN = false;
    u16* O; const float* rrow;
    __device__ __forceinline__ void operator()(const f32x4 (&acc)[2][2][4][2], const Unit& u, int wr, int wc, int fr, int fq) const {
        const int row0 = u.pm * BM + wr * 64 + fr; const int col0 = u.pn * BM + wc * 32 + 8 * fq;
#pragma unroll
        for (int ai = 0; ai < 2; ++ai)
#pragma unroll
            for (int m = 0; m < 4; ++m) { const int row = row0 + ai * HALF + m * 16; const float rs = rrow[row]; u16* rowp = O + (size_t)row * NP + col0;
#pragma unroll
                for (int bj = 0; bj < 2; ++bj) { const f32x4 v0 = acc[ai][bj][m][0] * rs, v1 = acc[ai][bj][m][1] * rs;
                    u32x4 w; w.x = pk2(v0[0], v0[1]); w.y = pk2(v0[2], v0[3]); w.z = pk2(v1[0], v1[1]); w.w = pk2(v1[2], v1[3]);
                    *(u32x4*)(rowp + bj * HALF) = w; } }
    }
};
struct EpiProj2 {
    static constexpr bool PERM = true, AFTER_DRAIN = false;
    u16* O; const float* rss;
    __device__ __forceinline__ void operator()(const f32x4 (&acc)[2][2][4][2], const Unit& u, int wr, int wc, int fr, int fq) const {
        const int row0 = u.pm * BM + wr * 64 + fr; const int col0 = u.pn * BM + wc * 32 + 8 * fq;
#pragma unroll
        for (int ai = 0; ai < 2; ++ai)
#pragma unroll
            for (int m = 0; m < 4; ++m) { const int row = row0 + ai * HALF + m * 16; const f32x4* pr = (const f32x4*)(rss + (size_t)row * 16);
                const f32x4 p0 = pr[0], p1 = pr[1], p2 = pr[2], p3 = pr[3]; const f32x4 ps = (p0 + p1) + (p2 + p3);
                const float rs = rsqrtf(((ps[0] + ps[1]) + (ps[2] + ps[3])) * (1.0f / DM) + EPS); u16* rowp = O + (size_t)row * NP + col0;
#pragma unroll
                for (int bj = 0; bj < 2; ++bj) { const f32x4 v0 = acc[ai][bj][m][0] * rs, v1 = acc[ai][bj][m][1] * rs;
                    u32x4 w; w.x = pk2(v0[0], v0[1]); w.y = pk2(v0[2], v0[3]); w.z = pk2(v1[0], v1[1]); w.w = pk2(v1[2], v1[3]);
                    *(u32x4*)(rowp + bj * HALF) = w; } }
    }
};
struct EpiResNext {
    static constexpr bool PERM = false, AFTER_DRAIN = false;
    const float* base; float* out; u16* xn; float* rss;
    __device__ __forceinline__ void operator()(const f32x4 (&acc)[2][2][4][2], const Unit& u, int wr, int wc, int fr, int fq) const {
        const int row0 = u.pm * BM + wr * 64 + fr; const int col0 = u.pn * BM + wc * 32 + 4 * fq;
#pragma unroll
        for (int ai = 0; ai < 2; ++ai)
#pragma unroll
            for (int m = 0; m < 4; ++m) { const int row = row0 + ai * HALF + m * 16; const size_t off = (size_t)row * DM + col0; float ss = 0.f;
#pragma unroll
                for (int bj = 0; bj < 2; ++bj)
#pragma unroll
                    for (int n = 0; n < 2; ++n) { const size_t o2 = off + bj * HALF + n * 16; const f32x4 o = *(const f32x4*)(base + o2) + acc[ai][bj][m][n]; *(f32x4*)(out + o2) = o;
                        u32x2 w; w.x = pk2(o[0], o[1]); w.y = pk2(o[2], o[3]); *(u32x2*)(xn + o2) = w; ss += (o[0] * o[0] + o[1] * o[1]) + (o[2] * o[2] + o[3] * o[3]); }
                ss += __shfl_xor(ss, 16); ss += __shfl_xor(ss, 32);
                if (fq == 0) rss[(size_t)row * 16 + u.pn * 4 + wc] = ss; }
    }
};
struct EpiRes {
    static constexpr bool PERM = false, AFTER_DRAIN = false;
    const float* base; float* out;
    __device__ __forceinline__ void operator()(const f32x4 (&acc)[2][2][4][2], const Unit& u, int wr, int wc, int fr, int fq) const {
        const int row0 = u.pm * BM + wr * 64 + fr; const int col0 = u.pn * BM + wc * 32 + 4 * fq;
#pragma unroll
        for (int ai = 0; ai < 2; ++ai)
#pragma unroll
            for (int m = 0; m < 4; ++m) { const size_t off = (size_t)(row0 + ai * HALF + m * 16) * DM + col0;
#pragma unroll
                for (int bj = 0; bj < 2; ++bj)
#pragma unroll
                    for (int n = 0; n < 2; ++n) { const size_t o2 = off + bj * HALF + n * 16; *(f32x4*)(out + o2) = *(const f32x4*)(base + o2) + acc[ai][bj][m][n]; } }
    }
};
template <class Epi, class Sched, bool ALIGN_EPI = false, bool SP2 = false>
__device__ __forceinline__ void gemm_phase(PG8_LAS unsigned char* lds, const Gemm g, const Sched& S, const Epi& E) {
    int tid_ = threadIdx.x; asm volatile("" : "+v"(tid_));
    const int tid = tid_, wid = __builtin_amdgcn_readfirstlane(tid >> 6), lane = tid & 63, wr = wid >> 2, wc = wid & 3, fr = lane & 15, fq = lane >> 4;
    const int K = g.K, nt = K / BK;
    unsigned voffA[2], voffB[2];
#pragma unroll
    for (int i = 0; i < 2; ++i) { int R, C; stage_rc(tid * 16 + i * 8192, R, C); const int Rb = Epi::PERM ? ((R & ~31) + perm32(R & 31)) : R;
        voffA[i] = (unsigned)(R * K + C) * 2u; voffB[i] = (unsigned)(Rb * K + C) * 2u; }
    const size_t kstep = (size_t)(BK * 2);
    const size_t hstep = (size_t)HALF * K * 2;
    const size_t tstep = 2 * hstep;
    const unsigned ldsw = (unsigned)wid * 1024u;
    const int aoff = lds_byte(wr * 64 + fr, fq * 8), boff = lds_byte(wc * 32 + fr, fq * 8);
#define PG8_SA(b, h) (((b) * 2 + (h)) * HTB)
#define PG8_SB(b, h) ((4 + (b) * 2 + (h)) * HTB)
#define PG8_STAGE(bufoff, gbase, voff) do { _Pragma("unroll") for (int _i = 0; _i < 2; ++_i) \
        __builtin_amdgcn_global_load_lds((const unsigned*)((const char*)(gbase) + (voff)[_i]), (PG8_LAS unsigned*)(lds + (bufoff) + ldsw + _i * 8192), 16, 0, 0); } while (0)
#define PG8_LDA(dst, b, h) do { _Pragma("unroll") for (int m = 0; m < 4; ++m) _Pragma("unroll") for (int k = 0; k < 2; ++k) dst[m][k] = *(const PG8_LAS bf16x8*)(lds + PG8_SA(b, h) + aoff + m * 2048 + k * 1024); } while (0)
#define PG8_LDB(dst, b, h) do { _Pragma("unroll") for (int n = 0; n < 2; ++n) _Pragma("unroll") for (int k = 0; k < 2; ++k) dst[n][k] = *(const PG8_LAS bf16x8*)(lds + PG8_SB(b, h) + boff + n * 2048 + k * 1024); } while (0)
#define PG8_MMA(ai, bj, At, Bt) do { __builtin_amdgcn_s_setprio(1); _Pragma("unroll") for (int m = 0; m < 4; ++m) _Pragma("unroll") for (int n = 0; n < 2; ++n) _Pragma("unroll") for (int k = 0; k < 2; ++k) \
        acc[ai][bj][m][n] = __builtin_amdgcn_mfma_f32_16x16x32_bf16(Bt[n][k], At[m][k], acc[ai][bj][m][n], 0, 0, 0); __builtin_amdgcn_s_setprio(0); } while (0)
#define PG8_WAIT_V(n) asm volatile("s_waitcnt vmcnt(" #n ")" ::: "memory")
#define PG8_WAIT_L(n) asm volatile("s_waitcnt lgkmcnt(" #n ")" ::: "memory")
#define PG8_BAR __builtin_amdgcn_s_barrier()
#define PG8_SCHED __builtin_amdgcn_sched_barrier(0)
    Unit cur, nxt; int ui = 0;
    if (!S.next(0, cur)) return;
    f32x4 acc[2][2][4][2];
#pragma unroll
    for (int a = 0; a < 2; ++a)
#pragma unroll
        for (int b = 0; b < 2; ++b)
#pragma unroll
            for (int m = 0; m < 4; ++m)
#pragma unroll
                for (int n = 0; n < 2; ++n) acc[a][b][m][n] = (f32x4){0.f, 0.f, 0.f, 0.f};
    bf16x8 At[4][2], B0[2][2], B1[2][2];
    const char* cA = (const char*)g.A + (size_t)cur.pm * tstep; const char* cB = (const char*)g.Bt + (size_t)cur.pn * tstep;
    S.a_ready(cur);
    if constexpr (SP2) {
        PG8_STAGE(PG8_SB(0, 0), cB, voffB); PG8_STAGE(PG8_SB(0, 1), cB + hstep, voffB); PG8_STAGE(PG8_SA(0, 0), cA, voffA); PG8_STAGE(PG8_SA(0, 1), cA + hstep, voffA);
        if (wr == 1) PG8_BAR;
        PG8_WAIT_V(2); PG8_BAR;
        PG8_STAGE(PG8_SB(1, 0), cB + kstep, voffB); PG8_STAGE(PG8_SA(1, 0), cA + kstep, voffA); PG8_STAGE(PG8_SB(1, 1), cB + hstep + kstep, voffB);
        PG8_WAIT_V(6); PG8_BAR;
    } else {
        PG8_STAGE(PG8_SB(0, 0), cB, voffB); PG8_STAGE(PG8_SA(0, 0), cA, voffA); PG8_STAGE(PG8_SB(0, 1), cB + hstep, voffB); PG8_STAGE(PG8_SA(0, 1), cA + hstep, voffA);
        if (wr == 1) PG8_BAR;
        PG8_WAIT_V(4); PG8_BAR;
        PG8_STAGE(PG8_SB(1, 0), cB + kstep, voffB); PG8_STAGE(PG8_SA(1, 0), cA + kstep, voffA); PG8_STAGE(PG8_SB(1, 1), cB + hstep + kstep, voffB);
        PG8_WAIT_V(6); PG8_BAR;
    }
    for (;;) {
        const bool has_next = S.next(ui + 1, nxt);
        const char* nA = has_next ? (const char*)g.A + (size_t)nxt.pm * tstep : cA; const char* nB = has_next ? (const char*)g.Bt + (size_t)nxt.pn * tstep : cB;
        for (int t = 0; t < nt; t += 2) {
            const bool last = (t == nt - 2);
            const char* a1 = cA + (size_t)(t + 1) * kstep;
            const char* a2 = last ? nA : cA + (size_t)(t + 2) * kstep; const char* b2 = last ? nB : cB + (size_t)(t + 2) * kstep;
            const char* a3 = a2 + kstep; const char* b3 = b2 + kstep;
            if (last && has_next) S.a_ready(nxt);
            if constexpr (SP2) {
            PG8_LDB(B0, 0, 0); PG8_LDB(B1, 0, 1); PG8_SCHED; PG8_LDA(At, 0, 0); PG8_STAGE(PG8_SA(1, 1), a1 + hstep, voffA);
            PG8_WAIT_V(8); PG8_WAIT_L(0); PG8_BAR; PG8_MMA(0, 0, At, B0); PG8_MMA(0, 1, At, B1); PG8_BAR; PG8_SCHED;
            PG8_LDA(At, 0, 1); PG8_STAGE(PG8_SB(0, 0), b2, voffB); PG8_STAGE(PG8_SB(0, 1), b2 + hstep, voffB); PG8_STAGE(PG8_SA(0, 0), a2, voffA);
            PG8_WAIT_V(8); PG8_WAIT_L(0); PG8_BAR; PG8_MMA(1, 0, At, B0); PG8_MMA(1, 1, At, B1); PG8_BAR; PG8_SCHED;
            PG8_LDB(B0, 1, 0); PG8_LDB(B1, 1, 1); PG8_SCHED; PG8_LDA(At, 1, 0); PG8_STAGE(PG8_SA(0, 1), a2 + hstep, voffA);
            PG8_WAIT_V(8); PG8_WAIT_L(0); PG8_BAR; PG8_MMA(0, 0, At, B0); PG8_MMA(0, 1, At, B1); PG8_BAR; PG8_SCHED;
            PG8_LDA(At, 1, 1); PG8_STAGE(PG8_SB(1, 0), b3, voffB); PG8_STAGE(PG8_SB(1, 1), b3 + hstep, voffB); PG8_STAGE(PG8_SA(1, 0), a3, voffA);
            PG8_WAIT_V(8); PG8_WAIT_L(0); PG8_BAR; PG8_MMA(1, 0, At, B0); PG8_MMA(1, 1, At, B1); PG8_BAR; PG8_SCHED;
            } else {
            PG8_LDB(B0, 0, 0); PG8_SCHED; PG8_LDA(At, 0, 0); PG8_STAGE(PG8_SA(1, 1), a1 + hstep, voffA);
            PG8_WAIT_L(8); PG8_BAR; PG8_WAIT_L(0); PG8_MMA(0, 0, At, B0); PG8_BAR; PG8_SCHED;
            PG8_LDB(B1, 0, 1); PG8_STAGE(PG8_SB(0, 0), b2, voffB);
            PG8_BAR; PG8_WAIT_L(0); PG8_MMA(0, 1, At, B1); PG8_BAR;
            PG8_LDA(At, 0, 1); PG8_STAGE(PG8_SA(0, 0), a2, voffA);
            PG8_BAR; PG8_WAIT_L(0); PG8_MMA(1, 0, At, B0); PG8_BAR; PG8_SCHED;
            PG8_STAGE(PG8_SB(0, 1), b2 + hstep, voffB);
            PG8_WAIT_V(6); PG8_BAR; PG8_MMA(1, 1, At, B1); PG8_BAR;
            PG8_LDB(B0, 1, 0); PG8_SCHED; PG8_LDA(At, 1, 0); PG8_STAGE(PG8_SA(0, 1), a2 + hstep, voffA);
            PG8_WAIT_L(8); PG8_BAR; PG8_WAIT_L(0); PG8_MMA(0, 0, At, B0); PG8_BAR; PG8_SCHED;
            PG8_LDB(B1, 1, 1); PG8_STAGE(PG8_SB(1, 0), b3, voffB);
            PG8_BAR; PG8_WAIT_L(0); PG8_MMA(0, 1, At, B1); PG8_BAR;
            PG8_LDA(At, 1, 1); PG8_STAGE(PG8_SA(1, 0), a3, voffA);
            PG8_BAR; PG8_WAIT_L(0); PG8_MMA(1, 0, At, B0); PG8_BAR; PG8_SCHED;
            PG8_STAGE(PG8_SB(1, 1), b3 + hstep, voffB);
            PG8_WAIT_V(6); PG8_BAR; PG8_MMA(1, 1, At, B1); PG8_BAR;
            }
        }
        if constexpr (ALIGN_EPI) { if (wr == 0) PG8_BAR; }
        if constexpr (!Epi::AFTER_DRAIN) { E(acc, cur, wr, wc, fr, fq); S.done(cur); }
        if (!has_next) break;
#pragma unroll
        for (int a = 0; a < 2; ++a)
#pragma unroll
            for (int b = 0; b < 2; ++b)
#pragma unroll
                for (int m = 0; m < 4; ++m)
#pragma unroll
                    for (int n = 0; n < 2; ++n) acc[a][b][m][n] = (f32x4){0.f, 0.f, 0.f, 0.f};
        cur = nxt; cA = nA; cB = nB; ++ui;
        if constexpr (ALIGN_EPI) { if (wr == 1) PG8_BAR; }
    }
    PG8_WAIT_V(0);
    if constexpr (!ALIGN_EPI) { if (wr == 0) PG8_BAR; }
    PG8_BAR;
    if constexpr (Epi::AFTER_DRAIN) { E.fused(acc, cur, wr, wc, fr, fq, lds, wid, lane); S.done(cur); }
#undef PG8_SA
#undef PG8_SB
#undef PG8_STAGE
#undef PG8_LDA
#undef PG8_LDB
#undef PG8_MMA
#undef PG8_WAIT_V
#undef PG8_WAIT_L
#undef PG8_BAR
#undef PG8_SCHED
}
}
template <int MAP> DI void wtile(LAS float* T, const float* src, int ld_src, const float* g, u16* dst, int Kdim, int n0, int k0) {
  int tid_ = threadIdx.x; asm volatile("" : "+v"(tid_)); const int tid = tid_;
#pragma unroll
  for (int i = 0; i < 8; ++i) {
    const int idx = tid + 512 * i, kk = idx >> 6, nn = idx & 63; int c = n0 + nn;
    if (MAP == 1) { c = c < 960 ? c : (c < 4288 ? c + 8 : (c < 4296 ? 960 + (c - 4288) : -1)); }
    float v = 0.f;
    if (c >= 0) { v = src[(size_t)(k0 + kk) * ld_src + c]; if (g) v *= g[k0 + kk]; if (MAP == 1 && n0 + nn >= C_QD && n0 + nn < C_QD + 256) v *= LOG2E * 0.125f; }
    T[nn * 65 + kk] = v;
  }
  __syncthreads();
#pragma unroll
  for (int i = 0; i < 8; ++i) { const int idx = tid + 512 * i, nn = idx >> 6, kk = idx & 63; dst[(size_t)(n0 + nn) * Kdim + k0 + kk] = f2bf(T[nn * 65 + kk]); }
  __syncthreads();
}
DI void prep_weights(const Params& p, LAS unsigned char* lds) {
  LAS float* T = (LAS float*)lds;
  constexpr int U_IN = (NP / 64) * (DM / 64), U_OUT = (DM / 64) * (DM / 64), U_KV = 4, U_L = U_IN + U_OUT + U_KV;
  for (int u = blockIdx.x; u < 2 * U_L; u += gridDim.x) {
    const int l = u / U_L; int r = u % U_L;
    if (r < U_IN) { wtile<1>(T, p.w_in + (size_t)l * DM * DIN, DIN, p.norm_g + l * DM, (u16*)(p.ws + WS_WIN) + (size_t)l * NP * DM, DM, (r / 16) * 64, (r % 16) * 64); }
    else if (r < U_IN + U_OUT) { r -= U_IN; wtile<0>(T, p.w_out + (size_t)l * DM * DM, DM, nullptr, (u16*)(p.ws + WS_WOUT) + (size_t)l * DM * DM, DM, (r / 16) * 64, (r % 16) * 64); }
    else { r -= U_IN + U_OUT; wtile<0>(T, p.w_kv_up + (size_t)l * 128 * 128, 128, p.kv_norm_g + l * 128, (u16*)(p.ws + WS_WKV) + (size_t)l * 128 * 128, 128, (r / 2) * 64, (r % 2) * 64); }
  }
}
DI void prep_x(const Params& p, const float* src) {
  int tid_ = threadIdx.x; asm volatile("" : "+v"(tid_)); const int lane = tid_ & 63, w = tid_ >> 6;
  u16* xb = (u16*)(p.ws + WS_XB); float* rrow = (float*)(p.ws + WS_RROW);
  for (int row = blockIdx.x * 8 + w; row < MTOK; row += gridDim.x * 8) {
    const float* xr = src + (size_t)row * DM; f32x4 v[4]; float ss = 0.f;
#pragma unroll
    for (int i = 0; i < 4; ++i) { v[i] = *(const f32x4*)(xr + lane * 4 + 256 * i); ss += v[i][0] * v[i][0] + v[i][1] * v[i][1] + v[i][2] * v[i][2] + v[i][3] * v[i][3]; }
    ss = sum64(ss);
#pragma unroll
    for (int i = 0; i < 4; ++i) { u32x2 o; o.x = pk2(v[i][0], v[i][1]); o.y = pk2(v[i][2], v[i][3]); *(u32x2*)(xb + (size_t)row * DM + lane * 4 + 256 * i) = o; }
    if (lane == 0) rrow[row] = rsqrtf(ss * (1.0f / DM) + EPS);
  }
}

template <int HP> DI void rope2(f32x2& x, int hl, const LAS f32x2* cs) {
  const float pa = __shfl_xor(x[0], HP), pb = __shfl_xor(x[1], HP);
  if (hl < HP) { const f32x2 c0 = cs[2 * hl], c1 = cs[2 * hl + 1]; x[0] = x[0] * c0[0] - pa * c0[1]; x[1] = x[1] * c1[0] - pb * c1[1]; }
  else if (hl < 2 * HP) { const f32x2 c0 = cs[2 * (hl - HP)], c1 = cs[2 * (hl - HP) + 1]; x[0] = x[0] * c0[0] + pa * c0[1]; x[1] = x[1] * c1[0] + pb * c1[1]; }
}
DI f32x2 unpk(unsigned w) { f32x2 r = {bflo(w), bfhi(w)}; return r; }

DI void post_unit(const Params& p, int l, int unit, LAS unsigned char* lds) {
  int tid_ = threadIdx.x; asm volatile("" : "+v"(tid_)); const int tid = tid_, lane = tid & 63, w = tid >> 6, hl = lane & 31, hsel = lane >> 5, hl16 = lane & 15;
  const int b = unit >> 7, n = unit & 127; const size_t tok0 = (size_t)b * S + n * 64;
  u16* proj = (u16*)(p.ws + WS_PROJ);
  LAS f32x2* cs16 = (LAS f32x2*)lds;
  LAS f32x2* cs8 = (LAS f32x2*)(lds + 4096);
  LAS f32x2* cs64 = (LAS f32x2*)(lds + 6144);
  LAS unsigned char* At = lds + 22528;
  for (int idx = tid; idx < 64 * 44; idx += 512) {
    const int t = idx / 44, a = idx % 44; const float pos = (float)p.pos[tok0 + t];
    float inv; LAS f32x2* dst;
    if (a < 8) { inv = powf(500000.0f, -(float)a * 2.0f / 16.0f); dst = cs16 + t * 8 + a; }
    else if (a < 12) { inv = powf(500000.0f, -(float)(a - 8) * 2.0f / 8.0f); dst = cs8 + t * 4 + (a - 8); }
    else { inv = powf(10000.0f, -(float)(a - 12) * 2.0f / 64.0f); dst = cs64 + t * 32 + (a - 12); }
    const float ang = pos * inv; const float kq = rintf(ang * 0.15915494309189535f);
    float rr = fmaf(-kq, 6.28125f, ang); rr = fmaf(-kq, 1.9353071795864769e-3f, rr);
    const float sn = sinf(rr), cs_ = cosf(rr);
    f32x2 v = {cs_, sn}; *dst = v;
  }
  __syncthreads();
  const float* qna = p.q_norm_a + l * 64; const float* qnc = p.q_norm_c + l * 32; const float* knc = p.k_norm_c + l * 32;
  for (int tp = 0; tp < 4; ++tp) {
    constexpr int segcol[16] = {C_QA, C_QA + 128, C_KA, C_QI, C_QI + 128, C_QI + 256, C_QI + 384, C_KI, C_QB, C_QB + 128, C_KB, C_KB + 128, C_QC, C_QC + 128, C_KC, C_KC + 128};
    unsigned raw2[2][16];
#pragma unroll
    for (int hf = 0; hf < 2; ++hf) { const u16* rowl = proj + (tok0 + w * 8 + 2 * tp + hf) * NP;
#pragma unroll
      for (int s = 0; s < 16; ++s) raw2[hf][s] = *(const unsigned*)(rowl + segcol[s] + 2 * lane); }
#pragma unroll
    for (int hf = 0; hf < 2; ++hf) {
    const int t = w * 8 + 2 * tp + hf; u16* row = proj + (tok0 + t) * NP;
#pragma unroll
    for (int s = 0; s < 16; ++s) {
      f32x2 x = unpk(raw2[hf][s]); u16* pp = row + segcol[s] + 2 * lane;
      if (s < 2) {
        const float rs = rsqrtf(sum32(x[0] * x[0] + x[1] * x[1]) * (1.0f / 64.0f) + EPS);
        x[0] *= rs * qna[2 * hl]; x[1] *= rs * qna[2 * hl + 1]; rope2<4>(x, hl, cs16 + t * 8);
        x *= LOG2E * 0.125f; *(unsigned*)pp = pk2(x[0], x[1]);
      } else if (s == 2) {
        const float rs = rsqrtf(sum64(x[0] * x[0] + x[1] * x[1]) * (1.0f / 128.0f) + EPS);
        *(LAS unsigned*)(At + t * 272 + lane * 4) = pk2(x[0] * rs, x[1] * rs);
      } else if (s < 7) {
        rope2<4>(x, hl, cs16 + t * 8); *(unsigned*)pp = pk2(x[0], x[1]);
      } else if (s == 7) {
        const float rs = rsqrtf(sum32(x[0] * x[0] + x[1] * x[1]) * (1.0f / 64.0f) + EPS);
        x *= rs; rope2<4>(x, hl, cs16 + t * 8); if (lane < 32) *(unsigned*)((u16*)(p.ws + WS_KIC) + (tok0 + t) * 64 + 2 * lane) = pk2(x[0], x[1]);
      } else if (s < 12) {
        rope2<16>(x, hl, cs64 + t * 32);
        const int hd = ((s & 1) ? 2 : 0) + hsel;
        const float lg = log1pf(-exp2f(-5.0f - (float)hd));
        const float f = (s < 10) ? expf(lg * (float)(t + 1)) : expf(lg * (float)(63 - t)) * 0.125f;
        x *= f; *(unsigned*)pp = pk2(x[0], x[1]);
      } else {
        const float* gn = (s < 14) ? qnc : knc;
        const float rs = rsqrtf(sum16(x[0] * x[0] + x[1] * x[1]) * (1.0f / 32.0f) + EPS);
        x[0] *= rs * gn[2 * hl16]; x[1] *= rs * gn[2 * hl16 + 1]; rope2<2>(x, hl16, cs8 + t * 4);
        if (s < 14) x *= LOG2E * 0.17677669529663687f;
        *(unsigned*)pp = pk2(x[0], x[1]);
      }
    }
    }
  }
  __syncthreads();
  if (w < 4) {
    const int tn = w & 1, part = w >> 1, r = lane & 31, h = lane >> 5;
    const u16* wkv = (const u16*)(p.ws + WS_WKV) + (size_t)l * 128 * 128;
    f32x16 c[2] = {zero16(), zero16()};
#pragma unroll
    for (int s = 0; s < 8; ++s) {
      const bf16x8 bfr = *(const LAS bf16x8*)(At + (32 * tn + r) * 272 + (16 * s + 8 * h) * 2);
#pragma unroll
      for (int mt = 0; mt < 2; ++mt) { const bf16x8 afr = *(const bf16x8*)(wkv + (size_t)(part * 64 + 32 * mt + r) * 128 + 16 * s + 8 * h); c[mt] = MFMA32(afr, bfr, c[mt]); }
    }
    const int t = 32 * tn + r; u16* row = proj + (tok0 + t) * NP;
    if (part == 0) {
      float ss = 0.f;
#pragma unroll
      for (int mt = 0; mt < 2; ++mt)
#pragma unroll
        for (int i = 0; i < 16; ++i) ss += c[mt][i] * c[mt][i];
      ss += __shfl_xor(ss, 32);
      const float rs = rsqrtf(ss * (1.0f / 64.0f) + EPS); const float* kna = p.k_norm_a + l * 64;
#pragma unroll
      for (int mt = 0; mt < 2; ++mt)
#pragma unroll
        for (int i = 0; i < 16; ++i) c[mt][i] *= rs * kna[32 * mt + crow(i, h)];
#pragma unroll
      for (int j = 0; j < 4; ++j) { const f32x2 cv = cs16[t * 8 + 4 * h + j]; const float x1 = c[0][j], x2 = c[0][4 + j]; c[0][j] = x1 * cv[0] - x2 * cv[1]; c[0][4 + j] = x2 * cv[0] + x1 * cv[1]; }
    }
    u16* dst = (u16*)(p.ws + WS_KVC) + (tok0 + t) * 128 + (part == 0 ? 0 : 64);
#pragma unroll
    for (int mt = 0; mt < 2; ++mt)
#pragma unroll
      for (int g = 0; g < 4; ++g) { u32x2 o; o.x = pk2(c[mt][4 * g], c[mt][4 * g + 1]); o.y = pk2(c[mt][4 * g + 2], c[mt][4 * g + 3]); *(u32x2*)(dst + 32 * mt + 8 * g + 4 * h) = o; }
  }
  __syncthreads();
}
constexpr int D_RS = 528;
constexpr int D_TILE = 64 * D_RS;
constexpr int D_KOFF = 0, D_VOFF = 2 * D_TILE, D_FLAG = 4 * D_TILE;

DI bf16x8 vfrag(LAS unsigned char* vt, int key0, int ecol, int lane) {
  const int q4 = (lane & 15) >> 2, p4 = lane & 3, blk = (lane >> 4) & 1;
  LAS unsigned char* a = vt + (key0 + q4) * D_RS + (ecol + 16 * blk + 4 * p4) * 2;
  const s16x4 lo = __builtin_amdgcn_ds_read_tr16_b64_v4i16((LAS s16x4*)a);
  const s16x4 hi = __builtin_amdgcn_ds_read_tr16_b64_v4i16((LAS s16x4*)(a + 8 * D_RS));
  return __builtin_shufflevector(lo, hi, 0, 1, 2, 3, 4, 5, 6, 7);
}

template <int MODE>
DI void dense_unit(const Params& p, int l, int b, int n, LAS unsigned char* lds) {
  constexpr int QCOL = MODE == 0 ? C_QC : (MODE == 1 ? C_QB : C_QD), KCOL = MODE == 0 ? C_KC : (MODE == 1 ? C_KB : C_KD);
  constexpr int VCOL = MODE == 0 ? C_VC : (MODE == 1 ? C_VB : C_VD), GCOL = MODE == 0 ? C_GC : (MODE == 1 ? C_GB : C_GD);
  constexpr int YCOL = MODE == 0 ? 512 : (MODE == 1 ? 256 : 768);
  int tid_ = threadIdx.x; asm volatile("" : "+v"(tid_)); const int tid = tid_, lane = tid & 63, w = tid >> 6, r = lane & 31, h = lane >> 5, hd = w >> 1, qh = w & 1;
  const u16* proj = (const u16*)(p.ws + WS_PROJ); u16* ybuf = (u16*)(p.ws + WS_XB);
  const size_t tq = (size_t)b * S + n * 64 + qh * 32 + r;
  const int iq = qh * 32 + r;
  bf16x8 qf[4];
#pragma unroll
  for (int s = 0; s < 4; ++s) qf[s] = *(const bf16x8*)(proj + tq * NP + QCOL + hd * 64 + 16 * s + 8 * h);
  LAS int* flag = (LAS int*)(lds + D_FLAG);
  const int ntiles = n + 1;
  u32x4 kr[4], vr[4];
  {
    const int m0 = (MODE == 2) ? n : 0; const u16* base = proj + ((size_t)b * S + m0 * 64) * NP;
#pragma unroll
    for (int i = 0; i < 4; ++i) { const int c = tid + 512 * i, row = c >> 5, c16 = c & 31; kr[i] = *(const u32x4*)(base + (size_t)row * NP + KCOL + c16 * 8); vr[i] = *(const u32x4*)(base + (size_t)row * NP + VCOL + c16 * 8); }
#pragma unroll
    for (int i = 0; i < 4; ++i) { const int c = tid + 512 * i, row = c >> 5, c16 = c & 31; *(LAS u32x4*)(lds + D_KOFF + row * D_RS + c16 * 16) = kr[i]; *(LAS u32x4*)(lds + D_VOFF + row * D_RS + c16 * 16) = vr[i]; }
    if (tid < 3) flag[tid] = 0;
  }
  __syncthreads();
  f32x16 o1[2] = {zero16(), zero16()}, o2[2] = {zero16(), zero16()};
  float l1 = 0.f, l2 = 0.f, carry = 1.0f;
  const float lg2g = log2f(1.0f - exp2f(-5.0f - (float)hd));
  const float cd = exp2f(lg2g * 64.0f);
  (void)l2; (void)carry; (void)cd; (void)lg2g; (void)iq;
#pragma unroll 1
  for (int it = 0; it < ntiles; ++it) {
    const int m = (MODE == 2) ? n - it : it, buf = it & 1; const bool has_next = it + 1 < ntiles;
    if (has_next) {
      const int mn = (MODE == 2) ? m - 1 : m + 1; const u16* base = proj + ((size_t)b * S + mn * 64) * NP;
#pragma unroll
      for (int i = 0; i < 4; ++i) { const int c = tid + 512 * i, row = c >> 5, c16 = c & 31; kr[i] = *(const u32x4*)(base + (size_t)row * NP + KCOL + c16 * 8); vr[i] = *(const u32x4*)(base + (size_t)row * NP + VCOL + c16 * 8); }
    }
    LAS unsigned char* kt = lds + D_KOFF + buf * D_TILE; LAS unsigned char* vt = lds + D_VOFF + buf * D_TILE;
    const bool diag = (m == n);
    if (MODE == 1) { if (it >= 1 && !diag) { o1[0] *= cd; o1[1] *= cd; } }
#pragma unroll
    for (int mi = 0; mi < 2; ++mi) {
      const int mt = (MODE == 2) ? 1 - mi : mi;
      LAS unsigned char* krow = kt + (32 * mt + r) * D_RS + (hd * 64 + 8 * h) * 2;
      const bf16x8 a0 = *(const LAS bf16x8*)(krow), a1 = *(const LAS bf16x8*)(krow + 32), a2 = *(const LAS bf16x8*)(krow + 64), a3 = *(const LAS bf16x8*)(krow + 96);
      if (MODE == 0) {
        f32x16 s1 = zero16(), s2 = zero16();
        s1 = MFMA32(a0, qf[0], s1); s1 = MFMA32(a1, qf[1], s1); s2 = MFMA32(a2, qf[2], s2); s2 = MFMA32(a3, qf[3], s2);
#pragma unroll
        for (int i = 0; i < 16; ++i) { s1[i] = fexp2(s1[i]); l1 += s1[i]; s2[i] = fexp2(s2[i]); l2 += s2[i]; }
#pragma unroll
        for (int s = 0; s < 2; ++s) {
          const bf16x8 p1 = pack8(s1, s), p2 = pack8(s2, s);
#pragma unroll
          for (int et = 0; et < 2; ++et) { const bf16x8 vf = vfrag(vt, 32 * mt + 16 * s + 4 * h, hd * 64 + 32 * et, lane); o1[et] = MFMA32(vf, p1, o1[et]); o2[et] = MFMA32(vf, p2, o2[et]); }
        }
      } else {
        f32x16 sc = zero16();
        sc = MFMA32(a0, qf[0], sc); sc = MFMA32(a1, qf[1], sc); sc = MFMA32(a2, qf[2], sc); sc = MFMA32(a3, qf[3], sc);
        if (MODE == 1) {
          if (diag) {
#pragma unroll
            for (int i = 0; i < 16; ++i) { const int jk = 32 * mt + crow(i, h); const float e = (jk <= iq) ? -64.0f : (float)(2 * (jk - iq) - 64); sc[i] *= fexp2(lg2g * e); }
          }
        } else {
          float rr[16];
#pragma unroll
          for (int i = 0; i < 16; ++i) { const float u = fexp2(sc[i]); float q = frcp(1.0f + u); if (diag) { const int jk = 32 * mt + crow(i, h); if (jk >= iq) q = 1.0f; } rr[i] = q; }
          float T[4], P2[4], P1[4];
#pragma unroll
          for (int g = 0; g < 4; ++g) { P2[g] = rr[4 * g + 3] * rr[4 * g + 2]; P1[g] = P2[g] * rr[4 * g + 1]; T[g] = P1[g] * rr[4 * g]; }
          float To[4], W[4];
#pragma unroll
          for (int g = 0; g < 4; ++g) { To[g] = __shfl_xor(T[g], 32); W[g] = T[g] * To[g]; }
          float suf[4]; suf[3] = 1.0f; suf[2] = W[3]; suf[1] = W[3] * W[2]; suf[0] = suf[1] * W[1];
          const float total = suf[0] * W[0];
#pragma unroll
          for (int g = 0; g < 4; ++g) {
            const float bs = carry * suf[g] * (h == 0 ? To[g] : 1.0f);
            sc[4 * g + 3] = (1.0f - rr[4 * g + 3]) * bs;
            sc[4 * g + 2] = (1.0f - rr[4 * g + 2]) * (bs * rr[4 * g + 3]);
            sc[4 * g + 1] = (1.0f - rr[4 * g + 1]) * (bs * P2[g]);
            sc[4 * g + 0] = (1.0f - rr[4 * g + 0]) * (bs * P1[g]);
          }
          carry *= total;
        }
#pragma unroll
        for (int s = 0; s < 2; ++s) {
          const bf16x8 p1 = pack8(sc, s);
#pragma unroll
          for (int et = 0; et < 2; ++et) { const bf16x8 vf = vfrag(vt, 32 * mt + 16 * s + 4 * h, hd * 64 + 32 * et, lane); o1[et] = MFMA32(vf, p1, o1[et]); }
        }
      }
    }
    if (has_next) {
      LAS unsigned char* kn = lds + D_KOFF + (buf ^ 1) * D_TILE; LAS unsigned char* vn = lds + D_VOFF + (buf ^ 1) * D_TILE;
#pragma unroll
      for (int i = 0; i < 4; ++i) { const int c = tid + 512 * i, row = c >> 5, c16 = c & 31; *(LAS u32x4*)(kn + row * D_RS + c16 * 16) = kr[i]; *(LAS u32x4*)(vn + row * D_RS + c16 * 16) = vr[i]; }
    }
    if (MODE == 2) {
      const int f3 = it % 3;
      if (__ballot(carry != 0.0f) != 0ull && lane == 0) flag[f3] = 1;
      if (tid == 0) flag[(it + 1) % 3] = 0;
      __syncthreads();
      if (flag[f3] == 0) break;
    } else {
      __syncthreads();
    }
  }
  float y[2][16];
  if (MODE == 0) {
    l1 += __shfl_xor(l1, 32); l2 += __shfl_xor(l2, 32);
    float s1 = 0.f, s2 = 0.f, s3 = 0.f, s4 = 0.f;
    for (int i = lane; i < 32; i += 64) { s1 += p.lam_q1[l * 32 + i] * p.lam_k1[l * 32 + i]; s2 += p.lam_q2[l * 32 + i] * p.lam_k2[l * 32 + i]; }
    s1 = sum64(s1); s2 = sum64(s2); (void)s3; (void)s4;
    const float li = lam_init_of(l), lam = expf(s1) - expf(s2) + li;
    const float i1 = 1.0f / l1, i2 = lam / l2; float ss = 0.f;
#pragma unroll
    for (int et = 0; et < 2; ++et)
#pragma unroll
      for (int i = 0; i < 16; ++i) { y[et][i] = o1[et][i] * i1 - o2[et][i] * i2; ss += y[et][i] * y[et][i]; }
    ss += __shfl_xor(ss, 32);
    const float rn = rsqrtf(ss * (1.0f / 64.0f) + EPS) * (1.0f - li);
#pragma unroll
    for (int et = 0; et < 2; ++et)
#pragma unroll
      for (int i = 0; i < 16; ++i) y[et][i] *= rn * p.subln_g[l * 64 + 32 * et + crow(i, h)];
  } else if (MODE == 1) {
    float sm = 0.f;
#pragma unroll
    for (int et = 0; et < 2; ++et)
#pragma unroll
      for (int i = 0; i < 16; ++i) sm += o1[et][i];
    sm += __shfl_xor(sm, 32); const float mu = sm * (1.0f / 64.0f); float sv = 0.f;
#pragma unroll
    for (int et = 0; et < 2; ++et)
#pragma unroll
      for (int i = 0; i < 16; ++i) { y[et][i] = o1[et][i] - mu; sv += y[et][i] * y[et][i]; }
    sv += __shfl_xor(sv, 32); const float rn = rsqrtf(sv * (1.0f / 64.0f) + EPS);
#pragma unroll
    for (int et = 0; et < 2; ++et)
#pragma unroll
      for (int i = 0; i < 16; ++i) y[et][i] *= rn * p.ret_norm_g[l * 256 + hd * 64 + 32 * et + crow(i, h)];
  } else {
#pragma unroll
    for (int et = 0; et < 2; ++et)
#pragma unroll
      for (int i = 0; i < 16; ++i) y[et][i] = o1[et][i];
  }
#pragma unroll
  for (int et = 0; et < 2; ++et)
#pragma unroll
    for (int g = 0; g < 4; ++g) {
      const int e0 = hd * 64 + 32 * et + 8 * g + 4 * h;
      const u32x2 gw = *(const u32x2*)(proj + tq * NP + GCOL + e0);
      u32x2 o; o.x = pk2(y[et][4 * g] * silu(bflo(gw.x)), y[et][4 * g + 1] * silu(bfhi(gw.x))); o.y = pk2(y[et][4 * g + 2] * silu(bflo(gw.y)), y[et][4 * g + 3] * silu(bfhi(gw.y)));
      *(u32x2*)(ybuf + tq * DM + YCOL + e0) = o;
    }
}
constexpr int KT_RS = 144;
DI bf16x8 vfrag144(LAS unsigned char* vt, int key0, int ecol, int lane) {
  const int q4 = (lane & 15) >> 2, p4 = lane & 3, blk = (lane >> 4) & 1;
  LAS unsigned char* a = vt + (key0 + q4) * KT_RS + (ecol + 16 * blk + 4 * p4) * 2;
  const s16x4 lo = __builtin_amdgcn_ds_read_tr16_b64_v4i16((LAS s16x4*)a);
  const s16x4 hi = __builtin_amdgcn_ds_read_tr16_b64_v4i16((LAS s16x4*)(a + 8 * KT_RS));
  return __builtin_shufflevector(lo, hi, 0, 1, 2, 3, 4, 5, 6, 7);
}

constexpr int W_RS = 144, W_TILE = 64 * W_RS, W_KOFF = 0, W_VOFF = 2 * W_TILE;

template <int MODE>
DI void dense256_unit(const Params& p, int l, int b, int nq, int hd, LAS unsigned char* lds) {
  constexpr int QCOL = MODE == 0 ? C_QC : C_QB, KCOL = MODE == 0 ? C_KC : C_KB, VCOL = MODE == 0 ? C_VC : C_VB, GCOL = MODE == 0 ? C_GC : C_GB, YCOL = MODE == 0 ? 512 : 256;
  int tid_ = threadIdx.x; asm volatile("" : "+v"(tid_)); const int tid = tid_, lane = tid & 63, w = tid >> 6, r = lane & 31, h = lane >> 5, qh = w & 1;
  const int cw = 4 * nq + (w >> 1);
  const u16* proj = (const u16*)(p.ws + WS_PROJ); u16* ybuf = (u16*)(p.ws + WS_XB);
  const size_t tq = (size_t)b * S + cw * 64 + qh * 32 + r;
  const int iq = qh * 32 + r;
  bf16x8 qf[4];
#pragma unroll
  for (int s = 0; s < 4; ++s) qf[s] = *(const bf16x8*)(proj + tq * NP + QCOL + hd * 64 + 16 * s + 8 * h);
  const int ntiles = 4 * nq + 4;
  const int lrow = tid >> 3, lc16 = tid & 7;
  const u16* kbase = proj + (size_t)b * S * NP + KCOL + hd * 64 + lc16 * 8; const u16* vbase = proj + (size_t)b * S * NP + VCOL + hd * 64 + lc16 * 8;
  u32x4 kr, vr;
  kr = *(const u32x4*)(kbase + (size_t)lrow * NP); vr = *(const u32x4*)(vbase + (size_t)lrow * NP);
  *(LAS u32x4*)(lds + W_KOFF + lrow * W_RS + lc16 * 16) = kr; *(LAS u32x4*)(lds + W_VOFF + lrow * W_RS + lc16 * 16) = vr;
  __syncthreads();
  f32x16 o1[2] = {zero16(), zero16()}, o2[2] = {zero16(), zero16()};
  float l1 = 0.f, l2 = 0.f;
  const float lg2g = log2f(1.0f - exp2f(-5.0f - (float)hd));
  const float cd = exp2f(lg2g * 64.0f);
  (void)l2; (void)cd; (void)lg2g; (void)iq;
#pragma unroll 1
  for (int m = 0; m < ntiles; ++m) {
    const int buf = m & 1; const bool has_next = m + 1 < ntiles;
    if (has_next) { kr = *(const u32x4*)(kbase + (size_t)((m + 1) * 64 + lrow) * NP); vr = *(const u32x4*)(vbase + (size_t)((m + 1) * 64 + lrow) * NP); }
    if (m <= cw) {
      LAS unsigned char* kt = lds + W_KOFF + buf * W_TILE; LAS unsigned char* vt = lds + W_VOFF + buf * W_TILE;
      const bool diag = (m == cw);
      if (MODE == 1) { if (m >= 1 && !diag) { o1[0] *= cd; o1[1] *= cd; } }
#pragma unroll
      for (int mt = 0; mt < 2; ++mt) {
        LAS unsigned char* krow = kt + (32 * mt + r) * W_RS + (8 * h) * 2;
        const bf16x8 a0 = *(const LAS bf16x8*)(krow), a1 = *(const LAS bf16x8*)(krow + 32), a2 = *(const LAS bf16x8*)(krow + 64), a3 = *(const LAS bf16x8*)(krow + 96);
        if (MODE == 0) {
          f32x16 s1 = zero16(), s2 = zero16();
          s1 = MFMA32(a0, qf[0], s1); s1 = MFMA32(a1, qf[1], s1); s2 = MFMA32(a2, qf[2], s2); s2 = MFMA32(a3, qf[3], s2);
#pragma unroll
          for (int i = 0; i < 16; ++i) { s1[i] = fexp2(s1[i]); l1 += s1[i]; s2[i] = fexp2(s2[i]); l2 += s2[i]; }
#pragma unroll
          for (int s = 0; s < 2; ++s) {
            const bf16x8 p1 = pack8(s1, s), p2 = pack8(s2, s);
#pragma unroll
            for (int et = 0; et < 2; ++et) { const bf16x8 vf = vfrag144(vt, 32 * mt + 16 * s + 4 * h, 32 * et, lane); o1[et] = MFMA32(vf, p1, o1[et]); o2[et] = MFMA32(vf, p2, o2[et]); }
          }
        } else {
          f32x16 sc = zero16();
          sc = MFMA32(a0, qf[0], sc); sc = MFMA32(a1, qf[1], sc); sc = MFMA32(a2, qf[2], sc); sc = MFMA32(a3, qf[3], sc);
          if (diag) {
#pragma unroll
            for (int i = 0; i < 16; ++i) { const int jk = 32 * mt + crow(i, h); const float e = (jk <= iq) ? -64.0f : (float)(2 * (jk - iq) - 64); sc[i] *= fexp2(lg2g * e); }
          }
#pragma unroll
          for (int s = 0; s < 2; ++s) {
            const bf16x8 p1 = pack8(sc, s);
#pragma unroll
            for (int et = 0; et < 2; ++et) { const bf16x8 vf = vfrag144(vt, 32 * mt + 16 * s + 4 * h, 32 * et, lane); o1[et] = MFMA32(vf, p1, o1[et]); }
          }
        }
      }
    }
    if (has_next) { *(LAS u32x4*)(lds + W_KOFF + (buf ^ 1) * W_TILE + lrow * W_RS + lc16 * 16) = kr; *(LAS u32x4*)(lds + W_VOFF + (buf ^ 1) * W_TILE + lrow * W_RS + lc16 * 16) = vr; }
    __syncthreads();
  }
  float y[2][16];
  if (MODE == 0) {
    l1 += __shfl_xor(l1, 32); l2 += __shfl_xor(l2, 32);
    float s1 = 0.f, s2 = 0.f;
    for (int i = lane; i < 32; i += 64) { s1 += p.lam_q1[l * 32 + i] * p.lam_k1[l * 32 + i]; s2 += p.lam_q2[l * 32 + i] * p.lam_k2[l * 32 + i]; }
    s1 = sum64(s1); s2 = sum64(s2);
    const float li = lam_init_of(l), lam = expf(s1) - expf(s2) + li;
    const float i1 = 1.0f / l1, i2 = lam / l2; float ss = 0.f;
#pragma unroll
    for (int et = 0; et < 2; ++et)
#pragma unroll
      for (int i = 0; i < 16; ++i) { y[et][i] = o1[et][i] * i1 - o2[et][i] * i2; ss += y[et][i] * y[et][i]; }
    ss += __shfl_xor(ss, 32);
    const float rn = rsqrtf(ss * (1.0f / 64.0f) + EPS) * (1.0f - li);
#pragma unroll
    for (int et = 0; et < 2; ++et)
#pragma unroll
      for (int i = 0; i < 16; ++i) y[et][i] *= rn * p.subln_g[l * 64 + 32 * et + crow(i, h)];
  } else {
    float sm = 0.f;
#pragma unroll
    for (int et = 0; et < 2; ++et)
#pragma unroll
      for (int i = 0; i < 16; ++i) sm += o1[et][i];
    sm += __shfl_xor(sm, 32); const float mu = sm * (1.0f / 64.0f); float sv = 0.f;
#pragma unroll
    for (int et = 0; et < 2; ++et)
#pragma unroll
      for (int i = 0; i < 16; ++i) { y[et][i] = o1[et][i] - mu; sv += y[et][i] * y[et][i]; }
    sv += __shfl_xor(sv, 32); const float rn = rsqrtf(sv * (1.0f / 64.0f) + EPS);
#pragma unroll
    for (int et = 0; et < 2; ++et)
#pragma unroll
      for (int i = 0; i < 16; ++i) y[et][i] *= rn * p.ret_norm_g[l * 256 + hd * 64 + 32 * et + crow(i, h)];
  }
#pragma unroll
  for (int et = 0; et < 2; ++et)
#pragma unroll
    for (int g = 0; g < 4; ++g) {
      const int e0 = hd * 64 + 32 * et + 8 * g + 4 * h;
      const u32x2 gw = *(const u32x2*)(proj + tq * NP + GCOL + e0);
      u32x2 o; o.x = pk2(y[et][4 * g] * silu(bflo(gw.x)), y[et][4 * g + 1] * silu(bfhi(gw.x))); o.y = pk2(y[et][4 * g + 2] * silu(bflo(gw.y)), y[et][4 * g + 3] * silu(bfhi(gw.y)));
      *(u32x2*)(ybuf + tq * DM + YCOL + e0) = o;
    }
}
constexpr int R_KT = 0, R_VT = 2 * W_TILE, R_ST = 4 * W_TILE, R_STAT = 6 * W_TILE;

DI void ret_scan_unit(const Params& p, int l, int b, int hd, LAS unsigned char* lds) {
  int tid_ = threadIdx.x; asm volatile("" : "+v"(tid_)); const int tid = tid_, lane = tid & 63, w = tid >> 6, r = lane & 31, h = lane >> 5;
  const u16* proj = (const u16*)(p.ws + WS_PROJ); u16* ybuf = (u16*)(p.ws + WS_XB);
  const int lrow = tid >> 3, lc16 = tid & 7;
  const u16* kbase = proj + (size_t)b * S * NP + C_KB + hd * 64 + lc16 * 8; const u16* vbase = proj + (size_t)b * S * NP + C_VB + hd * 64 + lc16 * 8;
  const float lg2g = log2f(1.0f - exp2f(-5.0f - (float)hd)), cd = exp2f(lg2g * 64.0f);
  const bool yw = w < 4;
  const int et = w & 1, tt = (w >> 1) & 1, dt = (w >> 1) & 1;
  const int iq = tt * 32 + r;
  for (int i = tid; i < 2 * W_TILE / 16; i += 512) { const u32x4 z = {0u, 0u, 0u, 0u}; *(LAS u32x4*)(lds + R_ST + i * 16) = z; }
  u32x4 kr = *(const u32x4*)(kbase + (size_t)lrow * NP), vr = *(const u32x4*)(vbase + (size_t)lrow * NP);
  *(LAS u32x4*)(lds + R_KT + lrow * W_RS + lc16 * 16) = kr; *(LAS u32x4*)(lds + R_VT + lrow * W_RS + lc16 * 16) = vr;
  f32x16 st = zero16();
  bf16x8 qf[4]; u32x2 gw[4];
  if (yw) {
    const size_t tq = (size_t)b * S + tt * 32 + r;
#pragma unroll
    for (int s = 0; s < 4; ++s) qf[s] = *(const bf16x8*)(proj + tq * NP + C_QB + hd * 64 + 16 * s + 8 * h);
#pragma unroll
    for (int g = 0; g < 4; ++g) gw[g] = *(const u32x2*)(proj + tq * NP + C_GB + hd * 64 + 32 * et + 8 * g + 4 * h);
  }
  float gn[16];
#pragma unroll
  for (int i = 0; i < 16; ++i) gn[i] = p.ret_norm_g[l * 256 + hd * 64 + 32 * et + crow(i, h)];
  __syncthreads();
#pragma unroll 1
  for (int n = 0; n < 128; ++n) {
    const int buf = n & 1; const bool has_next = n + 1 < 128;
    if (has_next) { kr = *(const u32x4*)(kbase + (size_t)((n + 1) * 64 + lrow) * NP); vr = *(const u32x4*)(vbase + (size_t)((n + 1) * 64 + lrow) * NP); }
    LAS unsigned char* kt = lds + R_KT + buf * W_TILE; LAS unsigned char* vt = lds + R_VT + buf * W_TILE;
    f32x16 o = zero16();
    bf16x8 qn[4]; u32x2 gwn[4];
    if (yw) {
      const size_t tqn = (size_t)b * S + (has_next ? n + 1 : n) * 64 + tt * 32 + r;
#pragma unroll
      for (int s = 0; s < 4; ++s) qn[s] = *(const bf16x8*)(proj + tqn * NP + C_QB + hd * 64 + 16 * s + 8 * h);
#pragma unroll
      for (int g = 0; g < 4; ++g) gwn[g] = *(const u32x2*)(proj + tqn * NP + C_GB + hd * 64 + 32 * et + 8 * g + 4 * h);
#pragma unroll
      for (int mt = 0; mt < 2; ++mt) {
        LAS unsigned char* krow = kt + (32 * mt + r) * W_RS + (8 * h) * 2;
        f32x16 sc = zero16();
#pragma unroll
        for (int s = 0; s < 4; ++s) sc = MFMA32(*(const LAS bf16x8*)(krow + 32 * s), qf[s], sc);
#pragma unroll
        for (int i = 0; i < 16; ++i) { const int jk = 32 * mt + crow(i, h); const float e = (jk <= iq) ? -64.0f : (float)(2 * (jk - iq) - 64); sc[i] *= fexp2(lg2g * e); }
#pragma unroll
        for (int s = 0; s < 2; ++s) { const bf16x8 pf = pack8(sc, s); const bf16x8 vf = vfrag144(vt, 32 * mt + 16 * s + 4 * h, 32 * et, lane); o = MFMA32(vf, pf, o); }
      }
      LAS unsigned char* srow = lds + R_ST + buf * W_TILE + (32 * et + r) * W_RS + (8 * h) * 2;
#pragma unroll
      for (int s = 0; s < 4; ++s) o = MFMA32(*(const LAS bf16x8*)(srow + 32 * s), qf[s], o);
      float sy = 0.f, sy2 = 0.f;
#pragma unroll
      for (int i = 0; i < 16; ++i) { sy += o[i]; sy2 += o[i] * o[i]; }
      sy = xsum32(sy); sy2 = xsum32(sy2);
      if (h == 0) { f32x2 v2 = {sy, sy2}; *(LAS f32x2*)(lds + R_STAT + ((buf * 4 + w) * 32 + r) * 8) = v2; }
    } else {
      st *= cd;
#pragma unroll
      for (int s = 0; s < 4; ++s) { const bf16x8 af = vfrag144(kt, 16 * s + 4 * h, 32 * dt, lane), bfr = vfrag144(vt, 16 * s + 4 * h, 32 * et, lane); st = MFMA32(af, bfr, st); }
      LAS unsigned char* sw = lds + R_ST + (buf ^ 1) * W_TILE + (32 * et + r) * W_RS + (32 * dt + 4 * h) * 2;
#pragma unroll
      for (int g = 0; g < 4; ++g) { u32x2 ow; ow.x = pk2(st[4 * g], st[4 * g + 1]); ow.y = pk2(st[4 * g + 2], st[4 * g + 3]); *(LAS u32x2*)(sw + 16 * g) = ow; }
    }
    if (has_next) { *(LAS u32x4*)(lds + R_KT + (buf ^ 1) * W_TILE + lrow * W_RS + lc16 * 16) = kr; *(LAS u32x4*)(lds + R_VT + (buf ^ 1) * W_TILE + lrow * W_RS + lc16 * 16) = vr; }
    __syncthreads();
    if (yw) {
      const f32x2 ps = *(const LAS f32x2*)(lds + R_STAT + ((buf * 4 + (w ^ 1)) * 32 + r) * 8);
      float sy = 0.f, sy2 = 0.f;
#pragma unroll
      for (int i = 0; i < 16; ++i) { sy += o[i]; sy2 += o[i] * o[i]; }
      sy = xsum32(sy) + ps[0]; sy2 = xsum32(sy2) + ps[1];
      const float mu = sy * (1.0f / 64.0f), var = fmaxf(sy2 * (1.0f / 64.0f) - mu * mu, 0.f), rn = rsqrtf(var + EPS);
      const size_t tq = (size_t)b * S + n * 64 + tt * 32 + r;
#pragma unroll
      for (int g = 0; g < 4; ++g) {
        const int e0 = hd * 64 + 32 * et + 8 * g + 4 * h;
        u32x2 ow; ow.x = pk2((o[4 * g] - mu) * rn * gn[4 * g] * silu(bflo(gw[g].x)), (o[4 * g + 1] - mu) * rn * gn[4 * g + 1] * silu(bfhi(gw[g].x)));
        ow.y = pk2((o[4 * g + 2] - mu) * rn * gn[4 * g + 2] * silu(bflo(gw[g].y)), (o[4 * g + 3] - mu) * rn * gn[4 * g + 3] * silu(bfhi(gw[g].y)));
        *(u32x2*)(ybuf + tq * DM + 256 + e0) = ow;
      }
#pragma unroll
      for (int s = 0; s < 4; ++s) qf[s] = qn[s];
#pragma unroll
      for (int g = 0; g < 4; ++g) gw[g] = gwn[g];
    }
  }
  __syncthreads();
}
constexpr int A_CAND = 0, A_KT = 98304, A_CAP = 768;
constexpr int KT_KEYS = 128, KT_BYTES = KT_KEYS * KT_RS, VT_BYTES = 32 * KT_RS;

DI void lds_wave_sync() { asm volatile("s_waitcnt lgkmcnt(0)" ::: "memory"); __builtin_amdgcn_wave_barrier(); asm volatile("" ::: "memory"); }
DI void wave_sync() { __builtin_amdgcn_fence(__ATOMIC_RELEASE, "wavefront"); __builtin_amdgcn_wave_barrier(); __builtin_amdgcn_fence(__ATOMIC_ACQUIRE, "wavefront"); }

template <int LIM> DI int topk_cut(LAS unsigned* cand, int cnt, unsigned& tauq, int lane) {
  if (cnt <= 256) return cnt;
  wave_sync();
  constexpr int NE = A_CAP / 64;
  unsigned e[NE];
#pragma unroll
  for (int i = 0; i < NE; ++i) { const int j = lane + 64 * i; e[i] = j < cnt ? cand[j] : 0u; }
  const unsigned ref = __builtin_amdgcn_readfirstlane(e[0]);
  unsigned df = 0u;
#pragma unroll
  for (int i = 0; i < NE; ++i) df |= (lane + 64 * i < cnt) ? (e[i] ^ ref) : 0u;
  df |= __shfl_xor(df, 1); df |= __shfl_xor(df, 2); df |= __shfl_xor(df, 4); df |= __shfl_xor(df, 8); df |= __shfl_xor(df, 16); df |= __shfl_xor(df, 32);
  df = __builtin_amdgcn_readfirstlane(df);
  const int hb = 31 - __builtin_clz(df | 1u);
  unsigned V = hb >= 31 ? 0u : (ref & ~((2u << hb) - 1u));
#pragma unroll 1
  for (int bit = hb; bit >= 0; --bit) {
    const unsigned cv = V | (1u << bit); int c = 0;
#pragma unroll
    for (int i = 0; i < NE; ++i) c += __popcll(__ballot(e[i] >= cv));
    if (c >= 256) V = cv;
    if (c >= 256 && c <= LIM) break;
  }
  int nc = 0;
#pragma unroll
  for (int i = 0; i < NE; ++i) {
    const bool pr = e[i] >= V; const unsigned long long bal = __ballot(pr);
    const int pos = nc + __popcll(bal & ((1ull << lane) - 1ull));
    if (pr) cand[pos] = e[i];
    nc += __popcll(bal);
  }
  wave_sync();
  tauq = V;
  return nc;
}

DI void dsa_unit(const Params& p, int l, int b, int g32, LAS unsigned char* lds) {
  int tid_ = threadIdx.x; asm volatile("" : "+v"(tid_)); const int tid = tid_, lane = tid & 63, w = tid >> 6, r = lane & 31, h = lane >> 5;
  const u16* proj = (const u16*)(p.ws + WS_PROJ); u16* ybuf = (u16*)(p.ws + WS_XB);
  const int n = g32 >> 1, end = (n + 1) * 64; const size_t tq0 = (size_t)b * S + g32 * 32 + 4 * w;
  LAS unsigned* cand = (LAS unsigned*)(lds + A_CAND) + (4 * w) * A_CAP;
  bf16x8 af[4];
  { const int ql = 2 * ((r >> 2) & 1) + (r >> 4), hdx = (((r >> 3) & 1) << 2) | (r & 3);
#pragma unroll
    for (int s = 0; s < 4; ++s) af[s] = *(const bf16x8*)(proj + (tq0 + ql) * NP + C_QI + hdx * 64 + 16 * s + 8 * h); }
  float w0[8], w1[8];
  { const u32x4 wa = *(const u32x4*)(proj + (tq0 + 2 * h) * NP + C_WI), wb = *(const u32x4*)(proj + (tq0 + 2 * h + 1) * NP + C_WI);
#pragma unroll
    for (int i = 0; i < 4; ++i) { w0[2 * i] = 0.5f * bflo(wa[i]); w0[2 * i + 1] = 0.5f * bfhi(wa[i]); w1[2 * i] = 0.5f * bflo(wb[i]); w1[2 * i + 1] = 0.5f * bfhi(wb[i]); } }
  int cnt0 = 0, cnt1 = 0, cnt2 = 0, cnt3 = 0; unsigned tau0 = 0u, tau1 = 0u, tau2 = 0u, tau3 = 0u;
  const u16* kglob = (const u16*)(p.ws + WS_KIC) + (size_t)b * S * 64;
  u32x4 krA[2], krB[2];
  const int kc0 = tid >> 3, kp0 = (tid & 7);
#define DSA_LOADT(R, tile) do { _Pragma("unroll") for (int i_ = 0; i_ < 2; ++i_) R[i_] = *(const u32x4*)(kglob + (size_t)((tile) * KT_KEYS + kc0 + 64 * i_) * 64 + kp0 * 8); } while (0)
#define DSA_STORET(R, bufi) do { _Pragma("unroll") for (int i_ = 0; i_ < 2; ++i_) *(LAS u32x4*)(lds + A_KT + (bufi) * KT_BYTES + (kc0 + 64 * i_) * KT_RS + kp0 * 16) = R[i_]; } while (0)
#define DSA_INSERT(v, KEYV, INR, tauv, QA, QB, cntA, cntB) do { \
    const unsigned f = __float_as_uint(v); const unsigned mono = f ^ ((unsigned)((int)f >> 31) | 0x80000000u); \
    const unsigned pk = (mono & 0xFFFFE000u) | (KEYV); \
    const bool pr = (pk > (tauv)) && (INR); \
    const unsigned long long bal = __builtin_amdgcn_ballot_w64(pr); \
    if (bal != 0ull) { \
      const unsigned m0 = (unsigned)bal, m1 = (unsigned)(bal >> 32); \
      const int pm0 = __popc(m0); \
      const int sA = (QA) * A_CAP + cntA, sB = (QB) * A_CAP + cntB - pm0;     \
      const int pos = (int)__builtin_amdgcn_mbcnt_hi(m1, __builtin_amdgcn_mbcnt_lo(m0, 0u)) + sA + (hneg & (sB - sA)); \
      if (pr) cand[pos] = pk; \
      cntA += pm0; cntB += __popc(m1); \
    } } while (0)
#define DSA_BODY(K0, BUFI) do { \
    LAS unsigned char* kt = lds + A_KT + (BUFI) * KT_BYTES + r * KT_RS + h * 16; \
    const int hneg = -h; const unsigned tauvA = h ? tau2 : tau0, tauvB = h ? tau3 : tau1;     \
    f32x16 acc[4];                      \
    _Pragma("unroll") for (int t = 0; t < 4; ++t) acc[t] = zero16(); \
    _Pragma("unroll") for (int s = 0; s < 4; ++s) \
      _Pragma("unroll") for (int t = 0; t < 4; ++t) { const bf16x8 kf = *(const LAS bf16x8*)(kt + (32 * t) * KT_RS + 32 * s); acc[t] = MFMA32(af[s], kf, acc[t]); } \
    float s0[4], s1[4]; \
    _Pragma("unroll") for (int t = 0; t < 4; ++t) { s0[t] = 0.f; s1[t] = 0.f; \
      _Pragma("unroll") for (int i = 0; i < 8; ++i) { s0[t] = fmaf(w0[i], acc[t][i], s0[t]); s0[t] = fmaf(w0[i], __builtin_fabsf(acc[t][i]), s0[t]); s1[t] = fmaf(w1[i], acc[t][8 + i], s1[t]); s1[t] = fmaf(w1[i], __builtin_fabsf(acc[t][8 + i]), s1[t]); } } \
    _Pragma("unroll") for (int t = 0; t < 4; ++t) { \
      const unsigned keyv = (unsigned)((K0) + 32 * t + r); const bool inr = (K0) + 32 * t < end; \
      DSA_INSERT(s0[t], keyv, inr, tauvA, 0, 2, cnt0, cnt2); \
      DSA_INSERT(s1[t], keyv, inr, tauvB, 1, 3, cnt1, cnt3); \
    } \
    if (cnt0 > A_CAP - KT_KEYS) cnt0 = topk_cut<272>(cand, cnt0, tau0, lane); \
    if (cnt1 > A_CAP - KT_KEYS) cnt1 = topk_cut<272>(cand + A_CAP, cnt1, tau1, lane); \
    if (cnt2 > A_CAP - KT_KEYS) cnt2 = topk_cut<272>(cand + 2 * A_CAP, cnt2, tau2, lane); \
    if (cnt3 > A_CAP - KT_KEYS) cnt3 = topk_cut<272>(cand + 3 * A_CAP, cnt3, tau3, lane); \
  } while (0)
  const int nstep = (end + KT_KEYS - 1) / KT_KEYS;
#if defined(PROBE_SEL2)
  for (int rep_ = 0; rep_ < 2; ++rep_) { cnt0 = cnt1 = cnt2 = cnt3 = 0; tau0 = tau1 = tau2 = tau3 = 0u; __syncthreads();
#endif
  LAS int* cflag = (LAS int*)(lds + A_KT + 2 * KT_BYTES);
  if (tid < 3) cflag[tid] = 0;
  DSA_LOADT(krA, 0);
  if (nstep > 1) DSA_LOADT(krB, 1);
  DSA_STORET(krA, 0);
  __syncthreads();
#define DSA_SYNC_CUT(STC) do { \
    const int fi_ = (STC) % 3; \
    if ((cnt0 > CUT_SOFT || cnt1 > CUT_SOFT || cnt2 > CUT_SOFT || cnt3 > CUT_SOFT) && lane == 0) cflag[fi_] = 1; \
    if (tid == 0) cflag[((STC) + 1) % 3] = 0; \
    __syncthreads(); \
    if (cflag[fi_] != 0) { \
      if (cnt0 > CUT_MIN) cnt0 = topk_cut<272>(cand, cnt0, tau0, lane); \
      if (cnt1 > CUT_MIN) cnt1 = topk_cut<272>(cand + A_CAP, cnt1, tau1, lane); \
      if (cnt2 > CUT_MIN) cnt2 = topk_cut<272>(cand + 2 * A_CAP, cnt2, tau2, lane); \
      if (cnt3 > CUT_MIN) cnt3 = topk_cut<272>(cand + 3 * A_CAP, cnt3, tau3, lane); \
    } } while (0)
  constexpr int CUT_SOFT = 560, CUT_MIN = 400;
#pragma unroll 1
  for (int st = 0; st < nstep; st += 2) {
    if (st + 2 < nstep) DSA_LOADT(krA, st + 2);
    DSA_BODY(st * KT_KEYS, 0);
    if (st + 1 < nstep) DSA_STORET(krB, 1);
    __syncthreads();
    if (st + 1 < nstep) {
      if (st + 3 < nstep) DSA_LOADT(krB, st + 3);
      DSA_BODY((st + 1) * KT_KEYS, 1);
      if (st + 2 < nstep) DSA_STORET(krA, 0);
      DSA_SYNC_CUT(st >> 1);
    }
  }
#undef DSA_SYNC_CUT
#if defined(PROBE_SEL2)
  }
#endif
#undef DSA_LOADT
#undef DSA_STORET
#undef DSA_BODY
#undef DSA_INSERT
  LAS unsigned char* vt = lds + A_KT + w * VT_BYTES;
  const u16* kvc = (const u16*)(p.ws + WS_KVC);
  const int ks = lane >> 3, dg = lane & 7;
#pragma unroll 1
  for (int qq = 0; qq < 4; ++qq) {
    const size_t tq = tq0 + qq;
    LAS unsigned* cq = cand + qq * A_CAP;
    unsigned tau_unused = 0u;
    const int nc = topk_cut<256>(cq, qq == 0 ? cnt0 : (qq == 1 ? cnt1 : (qq == 2 ? cnt2 : cnt3)), tau_unused, lane);
    wave_sync();
#if defined(PROBE_GAT2)
    for (int rep_ = 0; rep_ < 2; ++rep_) {
#endif
#if defined(PROBE_GAT2)
    for (int rep_ = 0; rep_ < 2; ++rep_) {
#endif
    bf16x8 qb[4];
#pragma unroll
    for (int s = 0; s < 4; ++s) { u32x4 z = {0u, 0u, 0u, 0u}; if (r < 4) z = *(const u32x4*)(proj + tq * NP + C_QA + r * 64 + 16 * s + 8 * h); qb[s] = __builtin_bit_cast(bf16x8, z); }
    f32x16 o[2] = {zero16(), zero16()}; float lsum = 0.f;
    u32x4 ka[4], va4[4];
    {
      const unsigned ik = cq[r] & 0x1FFFu; const u16* kp = kvc + ((size_t)b * S + ik) * 128 + 8 * h;
#pragma unroll
      for (int s = 0; s < 4; ++s) ka[s] = *(const u32x4*)(kp + 16 * s);
#pragma unroll
      for (int u = 0; u < 4; ++u) { const unsigned iv = cq[8 * u + ks] & 0x1FFFu; va4[u] = *(const u32x4*)(kvc + ((size_t)b * S + iv) * 128 + 64 + 8 * dg); }
    }
    const int ntile = nc >> 5;
#pragma unroll 1
    for (int mt = 0; mt < ntile; ++mt) {
      bf16x8 a[4];
#pragma unroll
      for (int s = 0; s < 4; ++s) a[s] = __builtin_bit_cast(bf16x8, ka[s]);
#pragma unroll
      for (int u = 0; u < 4; ++u) *(LAS u32x4*)(vt + (8 * u + ks) * KT_RS + dg * 16) = va4[u];
      if (mt + 1 < ntile) {
        const unsigned ik = cq[32 * (mt + 1) + r] & 0x1FFFu; const u16* kp = kvc + ((size_t)b * S + ik) * 128 + 8 * h;
#pragma unroll
        for (int s = 0; s < 4; ++s) ka[s] = *(const u32x4*)(kp + 16 * s);
#pragma unroll
        for (int u = 0; u < 4; ++u) { const unsigned iv = cq[32 * (mt + 1) + 8 * u + ks] & 0x1FFFu; va4[u] = *(const u32x4*)(kvc + ((size_t)b * S + iv) * 128 + 64 + 8 * dg); }
      }
      f32x16 sc = zero16();
#pragma unroll
      for (int s = 0; s < 4; ++s) sc = MFMA32(a[s], qb[s], sc);
#pragma unroll
      for (int i = 0; i < 16; ++i) { sc[i] = fexp2(sc[i]); lsum += sc[i]; }
      lds_wave_sync();
#pragma unroll
      for (int s = 0; s < 2; ++s) {
        const bf16x8 pf = pack8(sc, s);
#pragma unroll
        for (int et = 0; et < 2; ++et) { const bf16x8 vf = vfrag144(vt, 16 * s + 4 * h, 32 * et, lane); o[et] = MFMA32(vf, pf, o[et]); }
      }
      lds_wave_sync();
    }
    lsum = xsum32(lsum);
    if (r < 4) {
      const float inv = 1.0f / lsum;
#pragma unroll
      for (int et = 0; et < 2; ++et)
#pragma unroll
        for (int g = 0; g < 4; ++g) {
          const int e0 = r * 64 + 32 * et + 8 * g + 4 * h;
          const u32x2 gw = *(const u32x2*)(proj + tq * NP + C_GA + e0);
          u32x2 ow; ow.x = pk2(o[et][4 * g] * inv * silu(bflo(gw.x)), o[et][4 * g + 1] * inv * silu(bfhi(gw.x))); ow.y = pk2(o[et][4 * g + 2] * inv * silu(bflo(gw.y)), o[et][4 * g + 3] * inv * silu(bfhi(gw.y)));
          *(u32x2*)(ybuf + tq * DM + e0) = ow;
        }
    }
#if defined(PROBE_GAT2)
    wave_sync(); }
#endif
#if defined(PROBE_GAT2)
    wave_sync(); }
#endif
  }
  __syncthreads();
}
constexpr int MIX_UNITS_B = 516;

#if !defined(MULTI_LAUNCH)
__global__ void __launch_bounds__(512) hybrid_fwd(Params p) {
  extern __shared__ __attribute__((aligned(16))) unsigned char lds_g[];
  LAS unsigned char* lds = (LAS unsigned char*)lds_g;
  cg::grid_group grid = cg::this_grid();
  const int tid = threadIdx.x;
  unsigned* ctl = (unsigned*)(p.ws + WS_CTL);
  if (blockIdx.x == 0 && tid < 64) ctl[tid] = 0u;
  prep_weights(p, lds);
  prep_x(p, p.x);
  grid.sync();
#pragma unroll 1
  for (int l = 0; l < 2; ++l) {
    {
      pg8::StaticOrder so; so.init(MTOK, NP, (int)gridDim.x, (int)blockIdx.x);
      if (l == 0) {
        pg8::Gemm g{(const u16*)(p.ws + WS_XB), (const u16*)(p.ws + WS_WIN), MTOK, NP, DM};
        pg8::EpiProj E{(u16*)(p.ws + WS_PROJ), (const float*)(p.ws + WS_RROW)};
        pg8::gemm_phase<pg8::EpiProj, pg8::StaticOrder, true, true>(lds, g, so, E);
      } else {
        pg8::Gemm g{(const u16*)(p.ws + WS_XB2), (const u16*)(p.ws + WS_WIN) + (size_t)l * NP * DM, MTOK, NP, DM};
        pg8::EpiProj2 E{(u16*)(p.ws + WS_PROJ), (const float*)(p.ws + WS_RSS)};
        pg8::gemm_phase<pg8::EpiProj2, pg8::StaticOrder, true, true>(lds, g, so, E);
      }
    }
    grid.sync();
#pragma unroll 1
    for (int u = blockIdx.x; u < NB * 128; u += gridDim.x) post_unit(p, l, u, lds);
    grid.sync();
    {
      LAS int* slot = (LAS int*)(lds + LDS_BYTES - 16);
      const int q0 = (int)((unsigned)__builtin_amdgcn_s_getreg((3 << 11) | 20) & 7u);
#pragma unroll 1
      for (int qi = 0; qi < 8; ++qi) {
        const int bq = (q0 + qi) & 7;
#pragma unroll 1
        for (;;) {
          if (tid == 0) *slot = (int)atomicAdd(ctl + l * 8 + bq, 1u);
          __syncthreads();
          const int idx = *slot;
          __syncthreads();
          if (idx >= MIX_UNITS_B) break;
          if (idx < 4) ret_scan_unit(p, l, bq, idx, lds);
          else if (idx < 132) dense256_unit<0>(p, l, bq, 31 - ((idx - 4) & 31), (idx - 4) >> 5, lds);
          else if (idx < 388) dsa_unit(p, l, bq, 255 - (idx - 132), lds);
          else dense_unit<2>(p, l, bq, 127 - (idx - 388), lds);
        }
      }
    }
    grid.sync();
    {
      pg8::Gemm g{(const u16*)(p.ws + WS_XB), (const u16*)(p.ws + WS_WOUT) + (size_t)l * DM * DM, MTOK, DM, DM};
      pg8::StaticOrder so; so.init(MTOK, DM, (int)gridDim.x, (int)blockIdx.x);
      if (l == 0) { pg8::EpiResNext E{p.x, p.out, (u16*)(p.ws + WS_XB2), (float*)(p.ws + WS_RSS)}; pg8::gemm_phase<pg8::EpiResNext, pg8::StaticOrder, true, true>(lds, g, so, E); }
      else { pg8::EpiRes E{(const float*)p.out, p.out}; pg8::gemm_phase<pg8::EpiRes, pg8::StaticOrder, true, true>(lds, g, so, E); }
    }
    if (l == 0) grid.sync();
  }
}


#endif
#if defined(MULTI_LAUNCH)
template <int PH> __global__ void __launch_bounds__(512) phase_k(Params p, int l, int rep) {
  extern __shared__ __attribute__((aligned(16))) unsigned char lds_g[];
  LAS unsigned char* lds = (LAS unsigned char*)lds_g;
  const int tid = threadIdx.x; unsigned* ctl = (unsigned*)(p.ws + WS_CTL);
  if (PH == 0) { if (blockIdx.x == 0 && tid < 64) ctl[tid] = 0u; prep_weights(p, lds); prep_x(p, p.x); }
  if (PH == 1) { pg8::Gemm g{(const u16*)(p.ws + WS_XB), (const u16*)(p.ws + WS_WIN) + (size_t)l * NP * DM, MTOK, NP, DM};
      pg8::StaticOrder so; so.init(MTOK, NP, (int)gridDim.x, (int)blockIdx.x); pg8::EpiProj E{(u16*)(p.ws + WS_PROJ), (const float*)(p.ws + WS_RROW)};
      pg8::gemm_phase<pg8::EpiProj, pg8::StaticOrder, true, true>(lds, g, so, E); }
  if (PH == 2) { for (int u = blockIdx.x; u < NB * 128; u += gridDim.x) post_unit(p, l, u, lds); }
  if (PH >= 3 && PH <= 6) {
      LAS int* slot = (LAS int*)(lds + LDS_BYTES - 16);
      for (;;) {
        if (tid == 0) *slot = (int)atomicAdd(ctl + (l * 2 + rep) * 8 + (PH - 3), 1u);
        __syncthreads(); const int idx = *slot; __syncthreads();
        if (PH == 3) { if (idx >= 1024) break; dense256_unit<0>(p, l, idx & 7, 31 - (idx >> 5), (idx >> 3) & 3, lds); }
        if (PH == 4) { if (idx >= 32) break; ret_scan_unit(p, l, idx & 7, idx >> 3, lds); }
        if (PH == 5) { if (idx >= 2048) break; dsa_unit(p, l, idx & 7, 255 - (idx >> 3), lds); }
        if (PH == 6) { if (idx >= 1024) break; dense_unit<2>(p, l, idx & 7, 127 - (idx >> 3), lds); }
      } }
  if (PH == 7) { pg8::Gemm g{(const u16*)(p.ws + WS_XB), (const u16*)(p.ws + WS_WOUT) + (size_t)l * DM * DM, MTOK, DM, DM};
      pg8::StaticOrder so; so.init(MTOK, DM, (int)gridDim.x, (int)blockIdx.x); pg8::EpiRes E{l == 0 ? p.x : (const float*)p.out, p.out};
      pg8::gemm_phase<pg8::EpiRes, pg8::StaticOrder, true, true>(lds, g, so, E); }
  if (PH == 8) prep_x(p, p.out);
}
template <int PH> static void launch_phase(const Params& p, int l, hipStream_t stream, int rep = 0) {
  static bool attr = false; if (!attr) { (void)hipFuncSetAttribute((const void*)phase_k<PH>, hipFuncAttributeMaxDynamicSharedMemorySize, LDS_BYTES); attr = true; }
  hipLaunchKernelGGL(phase_k<PH>, dim3(256), dim3(512), LDS_BYTES, stream, p, l, rep);
}

#endif

extern "C" void kernel_launch(void* const* d_in, const int* in_sizes, int n_in, void* d_out, int out_size, void* d_ws, size_t ws_size, hipStream_t stream) {
  static int grid_blocks = 0;
  if (grid_blocks == 0) {
    if (n_in != 17 || in_sizes[0] != MTOK * DM || out_size != MTOK * DM || ws_size < WS_END) { fprintf(stderr, "kernel_launch: unexpected shapes (n_in %d, ws %zu, need %zu)\n", n_in, ws_size, (size_t)WS_END); grid_blocks = -1; return; }
    int dev = 0, cus = 0, per_cu = 0;
    (void)hipGetDevice(&dev); (void)hipDeviceGetAttribute(&cus, hipDeviceAttributeMultiprocessorCount, dev);
#if !defined(MULTI_LAUNCH)
    if (hipFuncSetAttribute((const void*)hybrid_fwd, hipFuncAttributeMaxDynamicSharedMemorySize, LDS_BYTES) != hipSuccess) { fprintf(stderr, "kernel_launch: hipFuncSetAttribute failed\n"); grid_blocks = -1; return; }
    if (hipOccupancyMaxActiveBlocksPerMultiprocessor(&per_cu, (const void*)hybrid_fwd, 512, LDS_BYTES) != hipSuccess || per_cu < 1) { fprintf(stderr, "kernel_launch: occupancy query says %d\n", per_cu); per_cu = 1; }
#else
    per_cu = 1;
#endif
    (void)hipGetLastError();
    grid_blocks = cus * per_cu;
  }
  if (grid_blocks < 0) return;
  Params p{};
  p.x = (const float*)d_in[0]; p.pos = (const int*)d_in[1]; p.norm_g = (const float*)d_in[2]; p.w_in = (const float*)d_in[3]; p.kv_norm_g = (const float*)d_in[4];
  p.w_kv_up = (const float*)d_in[5]; p.q_norm_a = (const float*)d_in[6]; p.k_norm_a = (const float*)d_in[7]; p.ret_norm_g = (const float*)d_in[8];
  p.q_norm_c = (const float*)d_in[9]; p.k_norm_c = (const float*)d_in[10]; p.lam_q1 = (const float*)d_in[11]; p.lam_k1 = (const float*)d_in[12];
  p.lam_q2 = (const float*)d_in[13]; p.lam_k2 = (const float*)d_in[14]; p.subln_g = (const float*)d_in[15]; p.w_out = (const float*)d_in[16];
  p.out = (float*)d_out; p.ws = (unsigned char*)d_ws;
#if defined(MULTI_LAUNCH)
  launch_phase<0>(p, 0, stream);
  for (int l = 0; l < 2; ++l) {
#ifndef DUP_PH
#define DUP_PH -1
#endif
    launch_phase<1>(p, l, stream); if (DUP_PH == 1) launch_phase<1>(p, l, stream, 1);
    launch_phase<2>(p, l, stream); if (DUP_PH == 2) { launch_phase<1>(p, l, stream, 1); launch_phase<2>(p, l, stream, 1); }
    launch_phase<3>(p, l, stream); if (DUP_PH == 3) launch_phase<3>(p, l, stream, 1);
    launch_phase<4>(p, l, stream); if (DUP_PH == 4) launch_phase<4>(p, l, stream, 1);
    launch_phase<5>(p, l, stream); if (DUP_PH == 5) launch_phase<5>(p, l, stream, 1);
    launch_phase<6>(p, l, stream); if (DUP_PH == 6) launch_phase<6>(p, l, stream, 1);
    launch_phase<7>(p, l, stream); if (DUP_PH == 7 && l == 0) launch_phase<7>(p, l, stream, 1);
    if (l == 0) { launch_phase<8>(p, l, stream); if (DUP_PH == 8) launch_phase<8>(p, l, stream, 1); }
  }
#else
  void* args[] = {&p};
  hipError_t e = hipLaunchCooperativeKernel((const void*)hybrid_fwd, dim3(grid_blocks), dim3(512), args, LDS_BYTES, stream);
  if (e != hipSuccess) fprintf(stderr, "cooperative launch failed: %s (grid %d)\n", hipGetErrorString(e), grid_blocks);
#endif
}
```
